# Optimizing an MI355X kernel written in HIP

```python
import jax
import jax.numpy as jnp
from jax import lax
import numpy as np

D_MODEL = 1024
BATCH = 2
SEQ = 16384
DEPTH = 1
DEC_BATCH = 8
DEC_SEQ = 8192
PAST_LEN = 128

GRID_W = 64
QBLK = 128
HD = 64
N_HEADS_A = 8
N_KV_A = 2
GROUP_A = N_HEADS_A // N_KV_A
N_HEADS_B = 8
N_HEADS_M = 4
HD_M = 128
N_MEM = 256
WIN_R_MAX = 8
WIN_C = 16
BRANCH_W = 512
N_BRANCH = 3
ROPE_THETA = 10000.0
ROPE_FREQS = HD // 4
EPS_QK = 1e-6
EPS_LN = 1e-5
DN_ALPHA = (2 * DEPTH) ** 0.25
DN_BETA = (8 * DEPTH) ** -0.25
NEG_INF = -1e30
SPLIT_SIZES = (N_HEADS_A * HD, N_KV_A * HD, N_KV_A * HD, BRANCH_W,
               N_HEADS_B * HD, N_HEADS_B * HD, N_HEADS_B * HD, BRANCH_W,
               N_HEADS_M * HD_M, BRANCH_W, N_BRANCH * D_MODEL)
SPLIT_POINTS = tuple(sum(SPLIT_SIZES[:i + 1]) for i in range(len(SPLIT_SIZES) - 1))
D_IN = sum(SPLIT_SIZES)

kernel_name = 'hybrid_gqa_natten_mem_encoder'


def _rms_norm(x, g):
    xf = x.astype(jnp.float32)
    y = xf * lax.rsqrt(jnp.mean(xf * xf, axis=-1, keepdims=True) + EPS_QK)
    return (y * g.astype(jnp.float32)).astype(x.dtype)


def _layer_norm(x, g, b):
    xf = x.astype(jnp.float32)
    mu = jnp.mean(xf, axis=-1, keepdims=True)
    var = jnp.mean(jnp.square(xf - mu), axis=-1, keepdims=True)
    y = (xf - mu) * lax.rsqrt(var + EPS_LN) * g.astype(jnp.float32) + b.astype(jnp.float32)
    return y.astype(x.dtype)


def _axial_rope_tables(n_tok):
    t = jnp.arange(n_tok)
    pos = jnp.stack([t // GRID_W, t % GRID_W], axis=-1).astype(jnp.float32)
    inv_freq = ROPE_THETA ** (-jnp.arange(ROPE_FREQS, dtype=jnp.float32) / ROPE_FREQS)
    ang = pos[:, :, None] * inv_freq
    return jnp.cos(ang), jnp.sin(ang)


def _apply_axial_rope(x, cos, sin):
    b, s, h, d = x.shape
    xf = x.astype(jnp.float32).reshape(b, s, h, 2, 2, ROPE_FREQS)
    x1, x2 = xf[..., 0, :], xf[..., 1, :]
    c = cos[None, :, None]
    sn = sin[None, :, None]
    out = jnp.stack([x1 * c - x2 * sn, x2 * c + x1 * sn], axis=-2)
    return out.reshape(b, s, h, d).astype(x.dtype)


def _global_gqa(q, k, v):
    b, s, _, _ = q.shape
    nb = s // QBLK
    qb = q.reshape(b, nb, QBLK, N_KV_A, GROUP_A, HD).transpose(1, 0, 2, 3, 4, 5)
    scale = HD ** -0.5

    def one_block(qi):
        sc = jnp.einsum('bqkgd,bskd->bkgqs', qi, k, preferred_element_type=jnp.float32) * scale
        p = jax.nn.softmax(sc, axis=-1).astype(v.dtype)
        return jnp.einsum('bkgqs,bskd->bqkgd', p, v)

    out = lax.map(one_block, qb)
    return out.transpose(1, 0, 2, 3, 4, 5).reshape(b, s, N_HEADS_A * HD)


def _neighbourhood_attn(q, k, v, rpb):
    b, s, h, d = q.shape
    rows = s // GRID_W
    win_r = min(WIN_R_MAX, rows)
    reg_r = min(win_r + 1, rows)
    rows_per_blk = QBLK // GRID_W
    nb = s // QBLK
    n_reg = reg_r * GRID_W
    kg = k.reshape(b, rows, GRID_W, h, d)
    vg = v.reshape(b, rows, GRID_W, h, d)
    qb = q.reshape(b, nb, QBLK, h, d).transpose(1, 0, 2, 3, 4)
    q_loc = jnp.arange(QBLK)
    k_loc = jnp.arange(n_reg)
    q_col = q_loc % GRID_W
    k_col = k_loc % GRID_W
    q_wc = jnp.clip(q_col - WIN_C // 2, 0, GRID_W - WIN_C)
    col_ok = (k_col[None] >= q_wc[:, None]) & (k_col[None] < q_wc[:, None] + WIN_C)
    dc = jnp.clip(k_col[None] - q_col[:, None] + WIN_C - 1, 0, 2 * WIN_C - 2)
    scale = d ** -0.5

    def one_block(args):
        i, qi = args
        r0 = i * rows_per_blk
        rs = jnp.clip(r0 - win_r // 2, 0, rows - reg_r)
        kb = lax.dynamic_slice_in_dim(kg, rs, reg_r, axis=1).reshape(b, n_reg, h, d)
        vb = lax.dynamic_slice_in_dim(vg, rs, reg_r, axis=1).reshape(b, n_reg, h, d)
        q_row = r0 + q_loc // GRID_W
        k_row = rs + k_loc // GRID_W
        q_wr = jnp.clip(q_row - win_r // 2, 0, rows - win_r)
        row_ok = (k_row[None] >= q_wr[:, None]) & (k_row[None] < q_wr[:, None] + win_r)
        dr = jnp.clip(k_row[None] - q_row[:, None] + WIN_R_MAX - 1, 0, 2 * WIN_R_MAX - 2)
        bias = rpb[:, dr, dc].astype(jnp.float32)
        sc = jnp.einsum('bqhd,bkhd->bhqk', qi, kb, preferred_element_type=jnp.float32) * scale + bias[None]
        sc = jnp.where((row_ok & col_ok)[None, None], sc, NEG_INF)
        p = jax.nn.softmax(sc, axis=-1).astype(vb.dtype)
        return jnp.einsum('bhqk,bkhd->bqhd', p, vb)

    out = lax.map(one_block, (jnp.arange(nb), qb))
    return out.transpose(1, 0, 2, 3, 4).reshape(b, s, h * d)


def _memory_attn(q, k, v):
    b, s, h, d = q.shape
    sc = jnp.einsum('bqhd,bmhd->bhqm', q, k, preferred_element_type=jnp.float32) * (d ** -0.5)
    p = jax.nn.softmax(sc, axis=-1).astype(v.dtype)
    return jnp.einsum('bhqm,bmhd->bqhd', p, v).reshape(b, s, h * d)


def _layer(x, mem, w_in, q_norm, k_norm, rpb, w_mem_kv, w_branch, w_out, ln_g, ln_b):
    b, s, _ = x.shape
    hproj = x @ w_in
    qa, ka, va, za, qb, kb, vb, zb, qm, zm, gl = jnp.split(hproj, SPLIT_POINTS, axis=-1)
    cos, sin = _axial_rope_tables(s)
    qa = _apply_axial_rope(_rms_norm(qa.reshape(b, s, N_HEADS_A, HD), q_norm), cos, sin)
    ka = _apply_axial_rope(_rms_norm(ka.reshape(b, s, N_KV_A, HD), k_norm), cos, sin)
    oa = _global_gqa(qa, ka, va.reshape(b, s, N_KV_A, HD))
    ob = _neighbourhood_attn(qb.reshape(b, s, N_HEADS_B, HD), kb.reshape(b, s, N_HEADS_B, HD),
                             vb.reshape(b, s, N_HEADS_B, HD), rpb)
    km, vm = jnp.split(mem @ w_mem_kv, 2, axis=-1)
    om = _memory_attn(qm.reshape(b, s, N_HEADS_M, HD_M), km.reshape(b, -1, N_HEADS_M, HD_M),
                      vm.reshape(b, -1, N_HEADS_M, HD_M))
    branches = jnp.stack([oa * jax.nn.silu(za), ob * jax.nn.silu(zb), om * jax.nn.silu(zm)], axis=2)
    proj = jnp.einsum('bsnc,ncd->bsnd', branches, w_branch)
    gates = jax.nn.sigmoid(gl.reshape(b, s, N_BRANCH, D_MODEL))
    merged = jnp.sum(gates * proj, axis=2)
    out = merged @ w_out
    return _layer_norm(DN_ALPHA * x + out, ln_g, ln_b)


def setup_inputs(seed: int = 0) -> dict:
    key = jax.random.key(seed)
    ks = jax.random.split(key, 13)
    f32 = jnp.float32
    x_prompt = jax.random.normal(ks[0], (BATCH, SEQ, D_MODEL), f32)
    x_sample = jax.random.normal(ks[1], (DEC_BATCH, DEC_SEQ, D_MODEL), f32)
    mem_prompt = jax.random.normal(ks[2], (BATCH, N_MEM, D_MODEL), f32)
    mem_sample = jax.random.normal(ks[3], (DEC_BATCH, N_MEM, D_MODEL), f32)
    w_in = jax.random.normal(ks[4], (DEPTH, D_MODEL, D_IN), f32) * D_MODEL ** -0.5
    q_norm = 1.0 + 0.01 * jax.random.normal(ks[5], (DEPTH, HD), f32)
    k_norm = 1.0 + 0.01 * jax.random.normal(ks[6], (DEPTH, HD), f32)
    rpb = 0.02 * jax.random.normal(ks[7], (DEPTH, N_HEADS_B, 2 * WIN_R_MAX - 1, 2 * WIN_C - 1), f32)
    w_mem_kv = jax.random.normal(ks[8], (DEPTH, D_MODEL, 2 * N_HEADS_M * HD_M), f32) * D_MODEL ** -0.5
    w_branch = jax.random.normal(ks[9], (DEPTH, N_BRANCH, BRANCH_W, D_MODEL), f32) * (BRANCH_W ** -0.5 * DN_BETA)
    w_out = jax.random.normal(ks[10], (DEPTH, D_MODEL, D_MODEL), f32) * (D_MODEL ** -0.5 * DN_BETA)
    ln_g = 1.0 + 0.01 * jax.random.normal(ks[11], (DEPTH, D_MODEL), f32)
    ln_b = 0.01 * jax.random.normal(ks[12], (DEPTH, D_MODEL), f32)
    return {'x_prompt': x_prompt, 'x_sample': x_sample, 'mem_prompt': mem_prompt, 'mem_sample': mem_sample,
            'w_in': w_in, 'q_norm': q_norm, 'k_norm': k_norm, 'rpb': rpb, 'w_mem_kv': w_mem_kv,
            'w_branch': w_branch, 'w_out': w_out, 'ln_g': ln_g, 'ln_b': ln_b}


def reference(x_prompt, x_sample, mem_prompt, mem_sample, w_in, q_norm, k_norm, rpb, w_mem_kv,
              w_branch, w_out, ln_g, ln_b):
    y_prompt = x_prompt
    y_sample = x_sample
    for l in range(DEPTH):
        y_prompt = _layer(y_prompt, mem_prompt, w_in[l], q_norm[l], k_norm[l], rpb[l], w_mem_kv[l],
                          w_branch[l], w_out[l], ln_g[l], ln_b[l])
        y_sample = _layer(y_sample, mem_sample, w_in[l], q_norm[l], k_norm[l], rpb[l], w_mem_kv[l],
                          w_branch[l], w_out[l], ln_g[l], ln_b[l])
    return (y_prompt, y_sample)
```

```cpp
#include <hip/hip_runtime.h>
#include <hip/hip_cooperative_groups.h>
#include <cstdio>
#include <cstdint>
namespace cg = cooperative_groups;

typedef unsigned short bf16_t;
typedef short bf16x8 __attribute__((ext_vector_type(8)));
typedef float f32x4 __attribute__((ext_vector_type(4)));
typedef float f32x16 __attribute__((ext_vector_type(16)));
typedef unsigned u32x4 __attribute__((ext_vector_type(4)));

#define DEVI __device__ __forceinline__

constexpr int NTHREADS = 512;
constexpr int CH = 16384;
constexpr int NCHUNK = 6;
constexpr int LDH = 7424;
constexpr int DM = 1024;
constexpr float LOG2E = 1.4426950408889634f;
constexpr float DN_ALPHA = 1.189207115002721f;
constexpr int SMEM_BYTES = 131072;

constexpr int C_QA = 0, C_KA = 512, C_VA = 640, C_ZA = 768, C_QB = 1280, C_KB = 1792, C_VB = 2304, C_ZB = 2816, C_QM = 3328, C_ZM = 3840, C_G = 4352;

struct Params {
    const float *x_prompt, *x_sample, *mem_prompt, *mem_sample, *w_in, *q_norm, *k_norm, *rpb, *w_mem_kv, *w_branch, *w_out, *ln_g, *ln_b;
    float* out;
    unsigned char* ws;
};
constexpr size_t al256(size_t x) { return (x + 255) & ~(size_t)255; }
constexpr size_t OFF_XB = 0;
constexpr size_t OFF_H = OFF_XB + al256((size_t)98304 * 1024 * 2);
constexpr size_t OFF_VAT = OFF_H + al256((size_t)CH * LDH * 2);
constexpr size_t OFF_VBT = OFF_VAT + 6 * al256((size_t)128 * CH * 2);
constexpr size_t OFF_MERGED = OFF_VBT + 6 * al256((size_t)512 * CH * 2);
constexpr size_t OFF_WT = OFF_MERGED + 6 * al256((size_t)CH * DM * 2);
constexpr size_t OFF_WBT = OFF_WT + al256((size_t)LDH * 1024 * 2);
constexpr size_t OFF_WOT = OFF_WBT + al256((size_t)3 * 1024 * 512 * 2);
constexpr size_t OFF_WKVT = OFF_WOT + al256((size_t)1024 * 1024 * 2);
constexpr size_t OFF_MEMB = OFF_WKVT + al256((size_t)1024 * 1024 * 2);
constexpr size_t OFF_KVM = OFF_MEMB + al256((size_t)2560 * 1024 * 2);
constexpr size_t OFF_VMT = OFF_KVM + al256((size_t)2560 * 512 * 2);
constexpr size_t OFF_ROPE = OFF_VMT + al256((size_t)10 * 512 * 256 * 2);
constexpr size_t OFF_KA = OFF_ROPE + al256((size_t)256 * 16 * 2 * 4);
constexpr size_t OFF_BAR = OFF_KA + 6 * al256((size_t)2 * CH * 64 * 2);
constexpr size_t OFF_MISC = OFF_BAR + 256;
constexpr size_t OFF_PANEL = OFF_MISC + 256;
constexpr size_t WS_END = OFF_PANEL + 2048;
#define WS_XB(p) ((bf16_t*)((p).ws + OFF_XB))
#define WS_H(p) ((bf16_t*)((p).ws + OFF_H))
#define WS_VAT(p) ((bf16_t*)((p).ws + OFF_VAT + (size_t)c * (128 * CH * 2)))
#define WS_VBT(p) ((bf16_t*)((p).ws + OFF_VBT + (size_t)c * (512 * CH * 2)))
#define WS_MERGED(p) ((bf16_t*)((p).ws + OFF_MERGED + (size_t)c * (CH * DM * 2)))
#define WS_WT(p) ((bf16_t*)((p).ws + OFF_WT))
#define WS_WBT(p) ((bf16_t*)((p).ws + OFF_WBT))
#define WS_WOT(p) ((bf16_t*)((p).ws + OFF_WOT))
#define WS_WKVT(p) ((bf16_t*)((p).ws + OFF_WKVT))
#define WS_MEMB(p) ((bf16_t*)((p).ws + OFF_MEMB))
#define WS_KVM(p) ((bf16_t*)((p).ws + OFF_KVM))
#define WS_VMT(p) ((bf16_t*)((p).ws + OFF_VMT))
#define WS_ROPE(p) ((float*)((p).ws + OFF_ROPE))
#define WS_KA(p) ((bf16_t*)((p).ws + OFF_KA + (size_t)c * (2 * CH * 64 * 2)))

typedef float f32x2 __attribute__((ext_vector_type(2)));
typedef __bf16 bf16x2n __attribute__((ext_vector_type(2)));
DEVI unsigned pk_bf16(float lo, float hi) { const f32x2 v = {lo, hi}; return __builtin_bit_cast(unsigned, __builtin_convertvector(v, bf16x2n)); }
DEVI bf16_t to_bf16(float f) { return (bf16_t)(pk_bf16(f, 0.f) & 0xffffu); }
DEVI float bf2f(bf16_t v) { return __uint_as_float(((unsigned)v) << 16); }
DEVI float fast_exp2(float x) { return __builtin_amdgcn_exp2f(x); }
DEVI float fast_rcp(float x) { return __builtin_amdgcn_rcpf(x); }
DEVI float sigmoidf_(float x) { return fast_rcp(1.f + fast_exp2(-x * LOG2E)); }
DEVI float siluf_(float x) { return x * sigmoidf_(x); }
DEVI int otid() { int t = threadIdx.x; asm volatile("" : "+v"(t)); return t; }
DEVI int obid() { int b = blockIdx.x; asm volatile("" : "+s"(b)); return b; }

typedef __attribute__((address_space(3))) unsigned char lds_u8;
typedef __attribute__((address_space(3))) unsigned lds_u32;
DEVI void glds16(const void* g, unsigned lds_off) {
    unsigned sv;
    asm volatile("s_mov_b32 %0, m0\n\ts_mov_b32 m0, %2\n\ts_nop 0\n\tglobal_load_lds_dwordx4 %1, off\n\ts_mov_b32 m0, %0" : "=&s"(sv) : "v"(g), "s"(__builtin_amdgcn_readfirstlane(lds_off)) : "memory");
}


DEVI void transpose_cvt(const float* __restrict__ src, bf16_t* __restrict__ dst, int K, int N, size_t gtid, size_t gsz) {
    const size_t total = (size_t)(K / 8) * N;
    for (size_t i = gtid; i < total; i += gsz) {
        const int n = (int)(i % N); const int k8 = (int)(i / N);
        const float* s = src + (size_t)k8 * 8 * N + n;
        float v0 = s[0], v1 = s[(size_t)N], v2 = s[(size_t)2 * N], v3 = s[(size_t)3 * N], v4 = s[(size_t)4 * N], v5 = s[(size_t)5 * N], v6 = s[(size_t)6 * N], v7 = s[(size_t)7 * N];
        uint4 o; o.x = pk_bf16(v0, v1); o.y = pk_bf16(v2, v3); o.z = pk_bf16(v4, v5); o.w = pk_bf16(v6, v7);
        *(uint4*)(dst + (size_t)n * K + k8 * 8) = o;
    }
}

DEVI void cvt_rows(const float* __restrict__ src, bf16_t* __restrict__ dst, size_t ngroups8, size_t gtid, size_t gsz) {
    for (size_t i = gtid; i < ngroups8; i += gsz) {
        const float4 a = ((const float4*)src)[i * 2], b = ((const float4*)src)[i * 2 + 1];
        uint4 o; o.x = pk_bf16(a.x, a.y); o.y = pk_bf16(a.z, a.w); o.z = pk_bf16(b.x, b.y); o.w = pk_bf16(b.z, b.w);
        ((uint4*)dst)[i] = o;
    }
}

__device__ void phase0(const Params& p) {
    const size_t gtid = (size_t)blockIdx.x * NTHREADS + threadIdx.x, gsz = (size_t)gridDim.x * NTHREADS;
    cvt_rows(p.x_prompt, WS_XB(p), (size_t)CH * 128, gtid, gsz);
    cvt_rows(p.mem_prompt, WS_MEMB(p), (size_t)512 * 128, gtid, gsz);
    cvt_rows(p.mem_sample, WS_MEMB(p) + (size_t)512 * 1024, (size_t)2048 * 128, gtid, gsz);
    transpose_cvt(p.w_in, WS_WT(p), 1024, LDH, gtid, gsz);
    transpose_cvt(p.w_mem_kv, WS_WKVT(p), 1024, 1024, gtid, gsz);
    transpose_cvt(p.w_out, WS_WOT(p), 1024, 1024, gtid, gsz);
    for (int n = 0; n < 3; ++n) transpose_cvt(p.w_branch + (size_t)n * 512 * 1024, WS_WBT(p) + (size_t)n * 1024 * 512, 512, 1024, gtid, gsz);
    if (gtid == 0) {
        float mq = 0.f, mk = 0.f;
        for (int i = 0; i < 64; ++i) { mq = fmaxf(mq, fabsf(p.q_norm[i])); mk = fmaxf(mk, fabsf(p.k_norm[i])); }
        ((float*)(p.ws + OFF_MISC))[0] = 8.f * mq * mk * LOG2E * 1.02f;
    }
    for (size_t i = gtid; i < 256 * 16; i += gsz) {
        const int pos = (int)(i >> 4), f = (int)(i & 15);
        const float inv = exp2f(-(float)f * (13.287712379549449f / 16.f));
        const float ang = (float)pos * inv;
        const double kd = rint((double)ang * 0.15915494309189535);
        const double r = (double)ang - kd * 6.283185307179586;
        const double r2 = r * r;
        double sn = r, cs = 1.0;
        {
            double ts = r, tc = 1.0;
#pragma unroll 1
            for (int n = 1; n <= 14; ++n) {
                tc = -tc * r2 / (double)((2 * n - 1) * (2 * n));
                ts = -ts * r2 / (double)((2 * n) * (2 * n + 1));
                cs += tc; sn += ts;
            }
        }
        WS_ROPE(p)[i * 2] = (float)cs; WS_ROPE(p)[i * 2 + 1] = (float)sn;
    }
}

DEVI void gemm_mainloop(const bf16_t* __restrict__ A, int lda, const bf16_t* __restrict__ Bt, int ldb, int K, unsigned char* smem, f32x4 (&acc)[8][4]) {
    constexpr int TB = 256 * 128;
    const int tid = otid(), lane = tid & 63, wid = tid >> 6, wr = wid >> 2, wc = wid & 3;
    const unsigned lds = (unsigned)(size_t)((lds_u8*)smem);
    unsigned goa[4], gob[4];
#pragma unroll
    for (int i = 0; i < 4; ++i) {
        const int row = 8 * (wid * 4 + i) + (lane >> 3);
        const int c = (lane & 7) ^ ((row >> 1) & 7);
        goa[i] = (unsigned)(row * lda + c * 8) * 2u; gob[i] = (unsigned)(row * ldb + c * 8) * 2u;
    }
    const unsigned ldsw = lds + wid * 4096;
    __syncthreads();
#define GM_ISSUE(k0_, st_) do { _Pragma("unroll") for (int i_ = 0; i_ < 4; ++i_) { glds16((const char*)A + goa[i_] + (k0_) * 2, ldsw + (st_) * (2 * TB) + i_ * 1024); glds16((const char*)Bt + gob[i_] + (k0_) * 2, ldsw + (st_) * (2 * TB) + TB + i_ * 1024); } } while (0)
#define GM_LOAD(a_, b_, sb_, xo_) do { _Pragma("unroll") for (int n_ = 0; n_ < 4; ++n_) b_[n_] = *(const bf16x8*)((sb_) + boff + n_ * 2048 + (xo_)); \
        _Pragma("unroll") for (int m_ = 0; m_ < 8; ++m_) a_[m_] = *(const bf16x8*)((sb_) + aoff + m_ * 2048 + (xo_)); } while (0)
#define GM_MMA(a_, b_) do { _Pragma("unroll") for (int m_ = 0; m_ < 8; ++m_) _Pragma("unroll") for (int n_ = 0; n_ < 4; ++n_) \
        acc[m_][n_] = __builtin_amdgcn_mfma_f32_16x16x32_bf16(a_[m_], b_[n_], acc[m_][n_], 0, 0, 0); } while (0)
    const int fr = lane & 15, fq = lane >> 4;
    const int x0 = (fq ^ ((fr >> 1) & 7)) << 4, x1 = x0 ^ 64;
    const int aoff = (wr * 128 + fr) * 128, boff = TB + (wc * 64 + fr) * 128;
    bf16x8 a0[8], b0[4], a1[8], b1[4];
    const int nk = K >> 6;
    GM_ISSUE(0, 0);
    asm volatile("s_waitcnt vmcnt(0) lgkmcnt(0)" ::: "memory");
    __builtin_amdgcn_s_barrier();
    asm volatile("" ::: "memory");
    GM_ISSUE(64, 1);
    GM_LOAD(a0, b0, smem, x0);
    GM_LOAD(a1, b1, smem, x1);
    GM_MMA(a0, b0);
#pragma unroll 1
    for (int kt = 1; kt < nk; ++kt) {
        asm volatile("s_waitcnt vmcnt(0) lgkmcnt(0)" ::: "memory");
        __builtin_amdgcn_s_barrier();
        asm volatile("" ::: "memory");
        if (kt + 1 < nk) GM_ISSUE((kt + 1) * 64, (kt + 1) & 1);
        const unsigned char* sb = smem + (kt & 1) * (2 * TB);
        GM_LOAD(a0, b0, sb, x0);
        GM_MMA(a1, b1);
        GM_LOAD(a1, b1, sb, x1);
        GM_MMA(a0, b0);
    }
    GM_MMA(a1, b1);
#undef GM_ISSUE
#undef GM_LOAD
#undef GM_MMA
    asm volatile("s_waitcnt lgkmcnt(0)" ::: "memory");
    __syncthreads();
}

DEVI void zero_acc(f32x4 (&acc)[8][4]) {
#pragma unroll
    for (int i = 0; i < 8; ++i)
#pragma unroll
        for (int j = 0; j < 4; ++j) acc[i][j] = (f32x4){0.f, 0.f, 0.f, 0.f};
}

DEVI void wave_coords(int m0, int n0, int& rbase, int& cbase, int& ncol) {
    const int tid = otid(), lane = tid & 63, wid = tid >> 6, wr = wid >> 2, wc = wid & 3;
    rbase = m0 + wr * 128 + (lane >> 4) * 4; ncol = n0 + wc * 64; cbase = ncol + (lane & 15);
}

template <class F>
DEVI void patch_pass(const f32x4 (&acc)[8][4], int mp, unsigned char* smem, F f) {
    const int t = otid(), lane = t & 63;
    float* patch = (float*)(smem + (t >> 6) * 8704);
#pragma unroll
    for (int m2 = 0; m2 < 2; ++m2)
#pragma unroll
        for (int ni = 0; ni < 4; ++ni)
#pragma unroll
            for (int r = 0; r < 4; ++r) patch[(m2 * 16 + (lane >> 4) * 4 + r) * 68 + ni * 16 + (lane & 15)] = acc[mp * 2 + m2][ni][r];
#pragma unroll
    for (int it = 0; it < 8; ++it) {
        const int row = it * 4 + (lane >> 4), col = (lane & 15) * 4;
        const f32x4 v = *(const f32x4*)(patch + row * 68 + col);
        f(mp * 32 + row, col, v);
    }
    __builtin_amdgcn_sched_barrier(0);
}
DEVI uint2 pack4(const f32x4 v) { uint2 w; w.x = pk_bf16(v[0], v[1]); w.y = pk_bf16(v[2], v[3]); return w; }
DEVI f32x4 unpack4(const uint2 w) { f32x4 v; v[0] = __uint_as_float(w.x << 16); v[1] = __uint_as_float(w.x & 0xffff0000u); v[2] = __uint_as_float(w.y << 16); v[3] = __uint_as_float(w.y & 0xffff0000u); return v; }

DEVI int remap_id(int id, int G) {
    if (G & 7) return id;
    const int rnd = id / G, b = id - rnd * G;
    return rnd * G + (b & 7) * (G >> 3) + (b >> 3);
}

DEVI void gemm1_epilogue(const Params& p, f32x4 (&acc)[8][4], int m0, int n0, int seqS, int c, unsigned char* smem) {
    const int tid = otid(), lane = tid & 63, wid = tid >> 6, wr = wid >> 2, wc = wid & 3;
    const int rw = m0 + wr * 128, ncol = n0 + wc * 64;
    bf16_t* H = WS_H(p);
    if (ncol >= C_VA && (ncol < C_ZA || (ncol >= C_VB && ncol < C_ZB))) {
        bf16_t* Vt = (ncol < C_ZA) ? WS_VAT(p) : WS_VBT(p);
        const int c0 = (ncol < C_ZA) ? C_VA : C_VB;
        const int rbase = rw + (lane >> 4) * 4, cbase = ncol + (lane & 15);
#pragma unroll
        for (int mi = 0; mi < 8; ++mi)
#pragma unroll
            for (int ni = 0; ni < 4; ++ni) {
                uint2 w; w.x = pk_bf16(acc[mi][ni][0], acc[mi][ni][1]); w.y = pk_bf16(acc[mi][ni][2], acc[mi][ni][3]);
                *(uint2*)(Vt + (size_t)(cbase + ni * 16 - c0) * CH + rbase + mi * 16) = w;
            }
        return;
    }
    if (ncol < C_VA) {
        const bool isq = ncol < C_KA;
        const float* g = isq ? p.q_norm : p.k_norm;
        float gv[4];
#pragma unroll
        for (int ni = 0; ni < 4; ++ni) gv[ni] = g[ni * 16 + (lane & 15)];
        const float sc = isq ? 0.125f * LOG2E : 1.f;
        const float2* rope = (const float2*)WS_ROPE(p);
        const int rbase = rw + (lane >> 4) * 4;
        bf16_t* dst = isq ? H + ncol + (lane & 15) : WS_KA(p) + (size_t)((ncol - C_KA) >> 6) * CH * 64 + (lane & 15);
        const int ldd = isq ? LDH : 64;
#pragma unroll
        for (int mi = 0; mi < 8; ++mi)
#pragma unroll
            for (int r = 0; r < 4; ++r) {
                float x0 = acc[mi][0][r], x1 = acc[mi][1][r], x2 = acc[mi][2][r], x3 = acc[mi][3][r];
                float ss = x0 * x0 + x1 * x1 + x2 * x2 + x3 * x3;
                ss += __shfl_xor(ss, 1); ss += __shfl_xor(ss, 2); ss += __shfl_xor(ss, 4); ss += __shfl_xor(ss, 8);
                const float rs = rsqrtf(ss * (1.f / 64.f) + 1e-6f);
                x0 *= rs * gv[0]; x1 *= rs * gv[1]; x2 *= rs * gv[2]; x3 *= rs * gv[3];
                const int row = rbase + mi * 16 + r;
                const int t = row & (seqS - 1);
                const float2 cr = rope[(t >> 6) * 16 + (lane & 15)], cc = rope[(t & 63) * 16 + (lane & 15)];
                const float y0 = x0 * cr.x - x1 * cr.y, y1 = x1 * cr.x + x0 * cr.y;
                const float y2 = x2 * cc.x - x3 * cc.y, y3 = x3 * cc.x + x2 * cc.y;
                bf16_t* o = dst + (size_t)row * ldd;
                o[0] = to_bf16(y0 * sc); o[16] = to_bf16(y1 * sc); o[32] = to_bf16(y2 * sc); o[48] = to_bf16(y3 * sc);
            }
        return;
    }
    int mode; float scale = 1.f;
    if (ncol >= C_G) mode = 3;
    else if (ncol >= C_ZM) mode = 2;
    else if (ncol >= C_QM) { mode = 0; scale = 0.08838834764831845f * LOG2E; }
    else if (ncol >= C_ZB) mode = 2;
    else if (ncol >= C_KB) mode = 0;
    else if (ncol >= C_QB) { mode = 0; scale = 0.125f * LOG2E; }
    else mode = 2;
    bf16_t* dst = H + (size_t)rw * LDH + ncol;
#pragma unroll
    for (int mp = 0; mp < 4; ++mp)
        patch_pass(acc, mp, smem, [&](int row, int col, f32x4 v) {
            if (mode == 0) { v = v * scale; }
            else if (mode == 2) {
#pragma unroll
                for (int k = 0; k < 4; ++k) v[k] = siluf_(v[k]);
            } else {
#pragma unroll
                for (int k = 0; k < 4; ++k) v[k] = sigmoidf_(v[k]);
            }
            *(uint2*)(dst + (size_t)row * LDH + col) = pack4(v);
        });
}

__device__ void phase5(const Params& p, int c, int part, int nparts);
__device__ void phase1(const Params& p, int c, unsigned char* smem) {
    const int G = gridDim.x;
    const int nN = LDH / 256;
    const int ntile = c == NCHUNK ? 0 : 64 * nN + (c == 0 ? 40 : 0);
    const int nround = ntile / G + 1;
    const int seqS = c < 2 ? 16384 : 8192;
    const bf16_t* xb = WS_XB(p) + (size_t)c * CH * DM;
    for (int id = obid(); id < nround * G; id += G) {
        const int v = remap_id(id, G);
        if (v >= ntile) {
            if (c > 0) phase5(p, c - 1, v - ntile, nround * G - ntile);
            if (c + 1 < NCHUNK) {
                const int cn = c + 1;
                const float* xs = cn < 2 ? p.x_prompt + (size_t)cn * CH * DM : p.x_sample + (size_t)(cn - 2) * CH * DM;
                cvt_rows(xs, WS_XB(p) + (size_t)cn * CH * DM, (size_t)CH * DM / 8, (size_t)(v - ntile) * NTHREADS + threadIdx.x, (size_t)(nround * G - ntile) * NTHREADS);
            }
            continue;
        }
        f32x4 acc[8][4];
        zero_acc(acc);
        int rbase, cbase, ncol;
        if (v < 64 * nN) {
            const int g = v / (8 * nN), r = v - g * 8 * nN;
            const int tm = g * 8 + (r & 7), tn = r >> 3;
            gemm_mainloop(xb + (size_t)tm * 256 * DM, DM, WS_WT(p) + (size_t)tn * 256 * DM, DM, DM, smem, acc);
            gemm1_epilogue(p, acc, tm * 256, tn * 256, seqS, c, smem);
        } else {
            const int v2 = v - 64 * nN;
            const int tm = v2 % 10, tn = v2 / 10;
            gemm_mainloop(WS_MEMB(p) + (size_t)tm * 256 * DM, DM, WS_WKVT(p) + (size_t)tn * 256 * DM, DM, DM, smem, acc);
            wave_coords(tm * 256, tn * 256, rbase, cbase, ncol);
#pragma unroll
            for (int mi = 0; mi < 8; ++mi)
#pragma unroll
                for (int ni = 0; ni < 4; ++ni) {
                    const int row = rbase + mi * 16, col = cbase + ni * 16;
                    if (ncol < 512) {
#pragma unroll
                        for (int r = 0; r < 4; ++r) WS_KVM(p)[(size_t)(row + r) * 512 + col] = to_bf16(acc[mi][ni][r]);
                    } else {
                        uint2 w; w.x = pk_bf16(acc[mi][ni][0], acc[mi][ni][1]); w.y = pk_bf16(acc[mi][ni][2], acc[mi][ni][3]);
                        const int sq = row >> 8, mm = row & 255;
                        *(uint2*)(WS_VMT(p) + ((size_t)sq * 512 + (col - 512)) * 256 + mm) = w;
                    }
                }
        }
    }
}

struct NaInfo { int krow0; int qrow; int q_wr; const float* bias; };

template <int D, int MODE>
DEVI void attn_block(const bf16_t* Q, int ldq, const bf16_t* __restrict__ Kp, int ldk, const bf16_t* __restrict__ Vt, int ldv, int nkt,
                     const bf16_t* Z, int ldz, bf16_t* O, int ldo, unsigned char* smem, const NaInfo na) {
    constexpr int KSTR = (D + 8) * 2;
    constexpr int KBYTES = 64 * KSTR;
    constexpr int VBYTES = D * 144;
    constexpr int STAGE = KBYTES + VBYTES;
    constexpr int NP = D * 8 / NTHREADS;
    constexpr int KPR = D / 8;
    constexpr bool PF = (D == 64);
    const int tid = otid(), lane = tid & 63, wid = tid >> 6;
    const int r31 = lane & 31, h = lane >> 5;
    bf16x8 qf[D / 16];
    {
        const bf16_t* qp = Q + (size_t)(wid * 32 + r31) * ldq + h * 8;
#pragma unroll
        for (int kk = 0; kk < D / 16; ++kk) qf[kk] = *(const bf16x8*)(qp + kk * 16);
    }
    f32x16 o[D / 32];
#pragma unroll
    for (int i = 0; i < D / 32; ++i)
#pragma unroll
        for (int j = 0; j < 16; ++j) o[i][j] = 0.f;
    float m_run = -1e30f, l_run = 0.f;
    u32x4 rk[NP], rv[NP];
    int kgo[NP], kso[NP], vgo[NP], vso[NP];
#pragma unroll
    for (int i = 0; i < NP; ++i) {
        const int pc = tid + NTHREADS * i;
        const int krow = pc / KPR, kc = pc % KPR;
        kgo[i] = krow * ldk + kc * 8; kso[i] = krow * KSTR + kc * 16;
        const int vrow = pc >> 3, vc = pc & 7;
        vgo[i] = vrow * ldv + vc * 8; vso[i] = KBYTES + vrow * 144 + vc * 16;
    }
#pragma unroll
    for (int i = 0; i < NP; ++i) { rk[i] = *(const u32x4*)(Kp + kgo[i]); rv[i] = *(const u32x4*)(Vt + vgo[i]); }
#pragma unroll
    for (int i = 0; i < NP; ++i) { *(u32x4*)(smem + kso[i]) = rk[i]; *(u32x4*)(smem + vso[i]) = rv[i]; }
    __syncthreads();
    const int pr = (r31 & 0x13) | ((r31 & 4) << 1) | ((r31 & 8) >> 1);
    const int kroff = pr * KSTR + h * 16;
    const int vroff = KBYTES + r31 * 144 + h * 16;
    int qcol = 0, q_wc = 0;
    if (MODE == 1) { qcol = (wid & 1) * 32 + r31; q_wc = min(max(qcol - 8, 0), 48); }
#pragma unroll 1
    for (int kt = 0; kt < nkt; ++kt) {
        const int buf = kt & 1;
        if (PF && kt + 1 < nkt) {
            const bf16_t* kn = Kp + (size_t)(kt + 1) * 64 * ldk;
            const bf16_t* vn = Vt + (kt + 1) * 64;
#pragma unroll
            for (int i = 0; i < NP; ++i) { rk[i] = *(const u32x4*)(kn + kgo[i]); rv[i] = *(const u32x4*)(vn + vgo[i]); }
        }
        bool need = true;
        int krow = 0;
        if (MODE == 1) { krow = na.krow0 + kt; need = (krow >= na.q_wr) && (krow < na.q_wr + 8); }
        if (need) {
            const unsigned char* sb = smem + buf * STAGE;
            f32x16 s[2];
#pragma unroll
            for (int kh = 0; kh < 2; ++kh) {
#pragma unroll
                for (int j = 0; j < 16; ++j) s[kh][j] = 0.f;
#pragma unroll
                for (int kk = 0; kk < D / 16; ++kk) {
                    const bf16x8 a = *(const bf16x8*)(sb + kroff + kh * 32 * KSTR + kk * 32);
                    s[kh] = __builtin_amdgcn_mfma_f32_32x32x16_bf16(a, qf[kk], s[kh], 0, 0, 0);
                }
            }
            if (MODE == 1) {
                const float* brow = na.bias + (krow - na.qrow + 7) * 128 + 48 + 15 + 8 * h - qcol;
                const int mb = 8 * h - q_wc;
#pragma unroll
                for (int kh = 0; kh < 2; ++kh)
#pragma unroll
                    for (int j = 0; j < 16; ++j) {
                        const int c0 = kh * 32 + 16 * (j >> 3) + (j & 7);
                        const float bv = brow[c0];
                        const bool ok = (unsigned)(c0 + mb) < 16u;
                        s[kh][j] = ok ? s[kh][j] + bv : -1e30f;
                    }
            }
            float mx = s[0][0];
#pragma unroll
            for (int j = 1; j < 16; ++j) mx = fmaxf(mx, s[0][j]);
#pragma unroll
            for (int j = 0; j < 16; ++j) mx = fmaxf(mx, s[1][j]);
            mx = fmaxf(mx, __shfl_xor(mx, 32));
            const float m_new = fmaxf(m_run, mx);
            const float alpha = fast_exp2(m_run - m_new);
            m_run = m_new;
            float ls = 0.f;
            bf16x8 pf[2][2];
#pragma unroll
            for (int kh = 0; kh < 2; ++kh)
#pragma unroll
                for (int sp = 0; sp < 2; ++sp) {
                    float e[8];
#pragma unroll
                    for (int j = 0; j < 8; ++j) { e[j] = fast_exp2(s[kh][sp * 8 + j] - m_new); ls += e[j]; }
                    u32x4 cv; cv.x = pk_bf16(e[0], e[1]); cv.y = pk_bf16(e[2], e[3]); cv.z = pk_bf16(e[4], e[5]); cv.w = pk_bf16(e[6], e[7]);
                    pf[kh][sp] = __builtin_bit_cast(bf16x8, cv);
                }
            l_run = l_run * alpha + ls;
#pragma unroll
            for (int dh = 0; dh < D / 32; ++dh) {
#pragma unroll
                for (int j = 0; j < 16; ++j) o[dh][j] *= alpha;
#pragma unroll
                for (int kh = 0; kh < 2; ++kh)
#pragma unroll
                    for (int sp = 0; sp < 2; ++sp) {
                        const bf16x8 a = *(const bf16x8*)(sb + vroff + dh * 32 * 144 + (kh * 32 + sp * 16) * 2);
                        o[dh] = __builtin_amdgcn_mfma_f32_32x32x16_bf16(a, pf[kh][sp], o[dh], 0, 0, 0);
                    }
            }
        }
        if (kt + 1 < nkt) {
            if (!PF) {
                const bf16_t* kn = Kp + (size_t)(kt + 1) * 64 * ldk;
                const bf16_t* vn = Vt + (kt + 1) * 64;
#pragma unroll
                for (int i = 0; i < NP; ++i) { rk[i] = *(const u32x4*)(kn + kgo[i]); rv[i] = *(const u32x4*)(vn + vgo[i]); }
            }
            unsigned char* nb = smem + (buf ^ 1) * STAGE;
#pragma unroll
            for (int i = 0; i < NP; ++i) { *(u32x4*)(nb + kso[i]) = rk[i]; *(u32x4*)(nb + vso[i]) = rv[i]; }
        }
        __syncthreads();
    }
    const float lt = l_run + __shfl_xor(l_run, 32);
    const float inv = 1.f / lt;
    const bf16_t* zp = Z + (size_t)(wid * 32 + r31) * ldz;
    bf16_t* op = O + (size_t)(wid * 32 + r31) * ldo;
#pragma unroll
    for (int dh = 0; dh < D / 32; ++dh)
#pragma unroll
        for (int g = 0; g < 4; ++g) {
            const int d0 = dh * 32 + 8 * g + 4 * h;
            const uint2 zz = *(const uint2*)(zp + d0);
            const float z0 = __uint_as_float(zz.x << 16), z1 = __uint_as_float(zz.x & 0xffff0000u), z2 = __uint_as_float(zz.y << 16), z3 = __uint_as_float(zz.y & 0xffff0000u);
            uint2 w;
            w.x = pk_bf16(o[dh][g * 4 + 0] * inv * z0, o[dh][g * 4 + 1] * inv * z1);
            w.y = pk_bf16(o[dh][g * 4 + 2] * inv * z2, o[dh][g * 4 + 3] * inv * z3);
            *(uint2*)(op + d0) = w;
        }
}

template <int MODE, int NH, bool BND>
DEVI void attn64(const bf16_t* Q, int ldq, const bf16_t* __restrict__ Kp, int ldk, const bf16_t* __restrict__ Vt, int ldv, int nkt,
                 const bf16_t* Z, int ldz, bf16_t* O, int ldo, unsigned char* smem, const NaInfo na, const float sbound = 0.f) {
    constexpr int STAGE = 16384;
    const int tid = otid(), lane = tid & 63, wid = tid >> 6;
    const int r31 = lane & 31, h = lane >> 5;
    const unsigned lds = (unsigned)(size_t)((lds_u8*)smem);
    bf16x8 qf[NH][4];
    {
        const bf16_t* qp = Q + (size_t)(wid * 32 + r31) * ldq + h * 8;
#pragma unroll
        for (int hh = 0; hh < NH; ++hh)
#pragma unroll
            for (int kk = 0; kk < 4; ++kk) qf[hh][kk] = *(const bf16x8*)(qp + hh * 64 + kk * 16);
#pragma unroll
        for (int hh = 0; hh < NH; ++hh)
#pragma unroll
            for (int kk = 0; kk < 4; ++kk) asm volatile("" : "+v"(qf[hh][kk]));
    }
    f32x16 o[NH][2];
    float m_run[NH], l_run[NH];
#pragma unroll
    for (int hh = 0; hh < NH; ++hh) {
        m_run[hh] = -1e30f; l_run[hh] = 0.f;
#pragma unroll
        for (int i = 0; i < 2; ++i)
#pragma unroll
            for (int j = 0; j < 16; ++j) o[hh][i][j] = 0.f;
    }
    int kgo, vgo;
    {
        const int row = 8 * wid + (lane >> 3);
        const int c = (lane & 7) ^ ((row >> 1) & 7);
        kgo = row * ldk + c * 8; vgo = row * ldv + c * 8;
    }
    const int ldsw = wid * 1024;
#define ATT_ISSUE(kt_, st_) do { const bf16_t* kb_ = Kp + (size_t)(kt_) * 64 * ldk; const bf16_t* vb_ = Vt + (kt_) * 64; \
        glds16(kb_ + kgo, lds + (st_) * STAGE + ldsw); glds16(vb_ + vgo, lds + (st_) * STAGE + 8192 + ldsw); } while (0)
    constexpr int NSUB = (MODE == 0) ? 4 : 2;
    constexpr int RMASK = 2 * NSUB - 1;
#pragma unroll
    for (int s_ = 0; s_ < NSUB; ++s_) if (s_ < nkt) ATT_ISSUE(s_, s_);
    const int pr = (r31 & 0x13) | ((r31 & 4) << 1) | ((r31 & 8) >> 1);
    const int kbase = pr * 128, kx = h ^ ((pr >> 1) & 7);
    const int vbase = 8192 + r31 * 128, vx = h ^ ((r31 >> 1) & 7);
    int koff[4], voff[4];
#pragma unroll
    for (int i = 0; i < 4; ++i) { koff[i] = kbase + (((2 * i) ^ kx) << 4); voff[i] = vbase + (((2 * i) ^ vx) << 4); }
    f32x16 negm;
#pragma unroll
    for (int j = 0; j < 16; ++j) negm[j] = BND ? -sbound : 0.f;
    int qcol = 0, q_wc = 0;
    if (MODE == 1) { qcol = (wid & 1) * 32 + r31; q_wc = min(max(qcol - 8, 0), 48); }
    int st = 0;
#pragma unroll 1
    for (int kt = 0; kt < nkt; kt += NSUB) {
        asm volatile("s_waitcnt vmcnt(0)" ::: "memory");
        __builtin_amdgcn_s_barrier();
        asm volatile("" ::: "memory");
#pragma unroll
        for (int s_ = 0; s_ < NSUB; ++s_) if (kt + NSUB + s_ < nkt) { const int sn_ = (st + NSUB + s_) & RMASK; ATT_ISSUE(kt + NSUB + s_, sn_); }
#pragma unroll 1
      for (int sub = 0; sub < NSUB; ++sub) {
        if (kt + sub >= nkt) break;
        bool need = true;
        int krow = 0;
        if (MODE == 1) { krow = na.krow0 + kt + sub; need = (krow >= na.q_wr) && (krow < na.q_wr + 8); }
        if (need) {
            const unsigned char* sb = smem + ((st + sub) & RMASK) * STAGE;
            f32x16 s[NH][2];
#pragma unroll
            for (int kh = 0; kh < 2; ++kh) {
#pragma unroll
                for (int hh = 0; hh < NH; ++hh) s[hh][kh] = negm;
#pragma unroll
                for (int kk = 0; kk < 4; ++kk) {
                    const bf16x8 a = *(const bf16x8*)(sb + koff[kk] + kh * 4096);
#pragma unroll
                    for (int hh = 0; hh < NH; ++hh) s[hh][kh] = __builtin_amdgcn_mfma_f32_32x32x16_bf16(a, qf[hh][kk], s[hh][kh], 0, 0, 0);
                }
            }
            bf16x8 pf[NH][2][2];
#pragma unroll
          for (int hh = 0; hh < NH; ++hh) {
            if (MODE == 1) {
                typedef __attribute__((address_space(3))) float lds_f32;
                const volatile lds_f32* brow = (const volatile lds_f32*)((lds_u8*)smem + 4 * 16384) + (krow - na.qrow + 7) * 128 + 48 + 15 + 8 * h - qcol;
                const int mb = 8 * h - q_wc;
#pragma unroll
                for (int kh = 0; kh < 2; ++kh)
#pragma unroll
                    for (int j = 0; j < 16; ++j) {
                        const int c0 = kh * 32 + 16 * (j >> 3) + (j & 7);
                        const float bv = brow[c0];
                        const bool ok = (unsigned)(c0 + mb) < 16u;
                        s[hh][kh][j] = ok ? s[hh][kh][j] + bv : -1e30f;
                    }
            }
            if (BND) {
                float ls = 0.f;
#pragma unroll
                for (int kh = 0; kh < 2; ++kh)
#pragma unroll
                    for (int sp = 0; sp < 2; ++sp) {
                        float e[8];
#pragma unroll
                        for (int j = 0; j < 8; ++j) { e[j] = fast_exp2(s[hh][kh][sp * 8 + j]); ls += e[j]; }
                        u32x4 cv; cv.x = pk_bf16(e[0], e[1]); cv.y = pk_bf16(e[2], e[3]); cv.z = pk_bf16(e[4], e[5]); cv.w = pk_bf16(e[6], e[7]);
                        pf[hh][kh][sp] = __builtin_bit_cast(bf16x8, cv);
                    }
                l_run[hh] += ls;
            } else {
                float mx = s[hh][0][0];
#pragma unroll
                for (int j = 1; j < 16; ++j) mx = fmaxf(mx, s[hh][0][j]);
#pragma unroll
                for (int j = 0; j < 16; ++j) mx = fmaxf(mx, s[hh][1][j]);
                mx = fmaxf(mx, __shfl_xor(mx, 32));
                const float m_new = fmaxf(m_run[hh], mx);
                const float alpha = fast_exp2(m_run[hh] - m_new);
                m_run[hh] = m_new;
                float ls = 0.f;
#pragma unroll
                for (int kh = 0; kh < 2; ++kh)
#pragma unroll
                    for (int sp = 0; sp < 2; ++sp) {
                        float e[8];
#pragma unroll
                        for (int j = 0; j < 8; ++j) { e[j] = fast_exp2(s[hh][kh][sp * 8 + j] - m_new); ls += e[j]; }
                        u32x4 cv; cv.x = pk_bf16(e[0], e[1]); cv.y = pk_bf16(e[2], e[3]); cv.z = pk_bf16(e[4], e[5]); cv.w = pk_bf16(e[6], e[7]);
                        pf[hh][kh][sp] = __builtin_bit_cast(bf16x8, cv);
                    }
                l_run[hh] = l_run[hh] * alpha + ls;
                if (__builtin_amdgcn_ballot_w64(alpha != 1.f) != 0ull) {
#pragma unroll
                    for (int dh = 0; dh < 2; ++dh)
#pragma unroll
                        for (int j = 0; j < 16; ++j) o[hh][dh][j] *= alpha;
                }
            }
          }
#pragma unroll
            for (int dh = 0; dh < 2; ++dh)
#pragma unroll
                for (int kh = 0; kh < 2; ++kh)
#pragma unroll
                    for (int sp = 0; sp < 2; ++sp) {
                        const bf16x8 a = *(const bf16x8*)(sb + voff[kh * 2 + sp] + dh * 4096);
#pragma unroll
                        for (int hh = 0; hh < NH; ++hh) o[hh][dh] = __builtin_amdgcn_mfma_f32_32x32x16_bf16(a, pf[hh][kh][sp], o[hh][dh], 0, 0, 0);
                    }
        }
      }
        st = (st + NSUB) & RMASK;
    }
#undef ATT_ISSUE
  const int te = otid();
  const int wide = te >> 6, r31e = te & 31;
#pragma unroll
  for (int hh = 0; hh < NH; ++hh) {
    const float lt = l_run[hh] + __shfl_xor(l_run[hh], 32);
    const float inv = 1.f / lt;
    const bf16_t* zp = Z + (size_t)(wide * 32 + r31e) * ldz + hh * 64;
    bf16_t* op = O + (size_t)(wide * 32 + r31e) * ldo + hh * 64;
#pragma unroll
    for (int dh = 0; dh < 2; ++dh)
#pragma unroll
        for (int g = 0; g < 4; ++g) {
            const int d0 = dh * 32 + 8 * g + 4 * h;
            const uint2 zz = *(const uint2*)(zp + d0);
            const float z0 = __uint_as_float(zz.x << 16), z1 = __uint_as_float(zz.x & 0xffff0000u), z2 = __uint_as_float(zz.y << 16), z3 = __uint_as_float(zz.y & 0xffff0000u);
            uint2 w;
            w.x = pk_bf16(o[hh][dh][g * 4 + 0] * inv * z0, o[hh][dh][g * 4 + 1] * inv * z1);
            w.y = pk_bf16(o[hh][dh][g * 4 + 2] * inv * z2, o[hh][dh][g * 4 + 3] * inv * z3);
            *(uint2*)(op + d0) = w;
        }
  }
    __syncthreads();
}

__device__ void phase2(const Params& p, int c, unsigned char* smem) {
    const int G = gridDim.x;
    const int ntile = 256 + 512 + 256;
    const int nround = (ntile + G - 1) / G;
    const int S = c < 2 ? 16384 : 8192;
    const int sq0 = c < 2 ? c : 2 + 2 * (c - 2);
    bf16_t* H = WS_H(p);
    const float sbound = ((const float*)(p.ws + OFF_MISC))[0];
    float* sbias = (float*)(smem + 4 * 16384);
    for (int id = obid(); id < nround * G; id += G) {
        const int v = remap_id(id, G);
        if (v >= ntile) continue;
        NaInfo na; na.krow0 = 0; na.qrow = 0; na.q_wr = 0; na.bias = sbias;
        if (v < 256) {
            const int head = ((v >> 5) & 3) * 2, qb = (v >> 7) * 32 + (v & 31);
            const int t0 = qb * 256;
            const int ks = (t0 / S) * S;
            const int kvh = head >> 2;
            if (sbound <= 40.f) attn64<0, 2, true>(H + (size_t)t0 * LDH + C_QA + head * 64, LDH, WS_KA(p) + ((size_t)kvh * CH + ks) * 64, 64,
                              WS_VAT(p) + (size_t)(kvh * 64) * CH + ks, CH, S / 64,
                              H + (size_t)t0 * LDH + C_ZA + head * 64, LDH, H + (size_t)t0 * LDH + C_QA + head * 64, LDH, smem, na, sbound);
            else attn64<0, 2, false>(H + (size_t)t0 * LDH + C_QA + head * 64, LDH, WS_KA(p) + ((size_t)kvh * CH + ks) * 64, 64,
                              WS_VAT(p) + (size_t)(kvh * 64) * CH + ks, CH, S / 64,
                              H + (size_t)t0 * LDH + C_ZA + head * 64, LDH, H + (size_t)t0 * LDH + C_QA + head * 64, LDH, smem, na);
        } else if (v < 768) {
            const int v2 = v - 256;
            const int head = (v2 >> 5) & 7, qb = (v2 >> 8) * 32 + (v2 & 31);
            const int t0 = qb * 256;
            const int ss = (t0 / S) * S;
            const int rows = S / 64;
            const int r0 = (t0 - ss) / 64;
            const int rs = min(max(r0 - 4, 0), rows - 11);
            const int wid = otid() >> 6;
            na.krow0 = rs; na.qrow = r0 + (wid >> 1); na.q_wr = min(max(na.qrow - 4, 0), rows - 8);
            for (int i = otid(); i < 15 * 128; i += NTHREADS) {
                const int dr = i >> 7, x = (i & 127) - 48;
                sbias[i] = (x >= 0 && x < 31) ? p.rpb[(head * 15 + dr) * 31 + x] * LOG2E : 0.f;
            }
            __syncthreads();
            const int kt0 = ss + rs * 64;
            attn64<1, 1, false>(H + (size_t)t0 * LDH + C_QB + head * 64, LDH, H + (size_t)kt0 * LDH + C_KB + head * 64, LDH,
                              WS_VBT(p) + (size_t)(head * 64) * CH + kt0, CH, 11,
                              H + (size_t)t0 * LDH + C_ZB + head * 64, LDH, H + (size_t)t0 * LDH + C_QB + head * 64, LDH, smem, na);
        } else {
            const int v2 = v - 768;
            const int head = (v2 >> 5) & 3, qb = (v2 >> 7) * 32 + (v2 & 31);
            const int t0 = qb * 256;
            const int sq = sq0 + t0 / S;
            attn_block<128, 0>(H + (size_t)t0 * LDH + C_QM + head * 128, LDH, WS_KVM(p) + (size_t)sq * 256 * 512 + head * 128, 512,
                               WS_VMT(p) + ((size_t)sq * 512 + head * 128) * 256, 256, 4,
                               H + (size_t)t0 * LDH + C_ZM + head * 128, LDH, H + (size_t)t0 * LDH + C_QM + head * 128, LDH, smem, na);
        }
    }
}

__device__ void phase3(const Params& p, int c, unsigned char* smem) {
    const int G = gridDim.x;
    const int ntile = 64 * 4;
    const int nround = (ntile + G - 1) / G;
    for (int id = obid(); id < nround * G; id += G) {
        const int v = remap_id(id, G);
        if (v >= ntile) continue;
        const int tm = v >> 2, tn = v & 3;
        int rbase, cbase, ncol;
        wave_coords(tm * 256, tn * 256, rbase, cbase, ncol);
#pragma unroll 1
        for (int n = 0; n < 3; ++n) {
            const int seg = n == 0 ? C_QA : (n == 1 ? C_QB : C_QM);
            f32x4 acc[8][4];
            zero_acc(acc);
            gemm_mainloop(WS_H(p) + (size_t)tm * 256 * LDH + seg, LDH, WS_WBT(p) + (size_t)n * 1024 * 512 + (size_t)tn * 256 * 512, 512, 512, smem, acc);
            {
                const int tid = otid(), wid = tid >> 6, wr = wid >> 2, wc = wid & 3;
                const int rw = tm * 256 + wr * 128, cw = tn * 256 + wc * 64;
                const bf16_t* gp = WS_H(p) + (size_t)rw * LDH + C_G + n * 1024 + cw;
                bf16_t* mg = WS_MERGED(p) + (size_t)rw * DM + cw;
#pragma unroll
                for (int mp = 0; mp < 4; ++mp)
                    patch_pass(acc, mp, smem, [&](int row, int col, f32x4 v) {
                        const f32x4 gt = unpack4(*(const uint2*)(gp + (size_t)row * LDH + col));
                        uint2* mp2 = (uint2*)(mg + (size_t)row * DM + col);
                        v = v * gt;
                        if (n > 0) v = v + unpack4(*mp2);
                        *mp2 = pack4(v);
                    });
            }
        }
        asm volatile("s_waitcnt vmcnt(0)" ::: "memory");
        __syncthreads();
        if (otid() == 0) {
            __builtin_amdgcn_fence(__ATOMIC_RELEASE, "agent");
            asm volatile("s_waitcnt vmcnt(0)" ::: "memory");
            __hip_atomic_fetch_add((unsigned*)(p.ws + OFF_PANEL) + c * 64 + tm, 1u, __ATOMIC_RELAXED, __HIP_MEMORY_SCOPE_AGENT);
        }
    }
}

__device__ void phase4(const Params& p, int c, unsigned char* smem) {
    const int G = gridDim.x;
    const int ntile = 64 * 4;
    const int nround = (ntile + G - 1) / G;
    const float* x = c < 2 ? p.x_prompt + (size_t)c * CH * DM : p.x_sample + (size_t)(c - 2) * CH * DM;
    float* out = p.out + (size_t)c * CH * DM;
    for (int id = obid(); id < nround * G; id += G) {
        const int v = remap_id(id, G);
        if (v >= ntile) continue;
        const int tm = v >> 2, tn = v & 3;
        int rbase, cbase, ncol;
        wave_coords(tm * 256, tn * 256, rbase, cbase, ncol);
        if (otid() == 0) {
            const unsigned* pc = (const unsigned*)(p.ws + OFF_PANEL) + c * 64 + tm;
            for (unsigned spins = 0; spins < (1u << 22); ++spins) {
                if (__hip_atomic_load(pc, __ATOMIC_RELAXED, __HIP_MEMORY_SCOPE_AGENT) >= 4u) break;
                __builtin_amdgcn_s_sleep(1);
            }
            __builtin_amdgcn_fence(__ATOMIC_ACQUIRE, "agent");
            asm volatile("s_waitcnt vmcnt(0)" ::: "memory");
        }
        __syncthreads();
        f32x4 acc[8][4];
        zero_acc(acc);
        gemm_mainloop(WS_MERGED(p) + (size_t)tm * 256 * DM, DM, WS_WOT(p) + (size_t)tn * 256 * DM, DM, DM, smem, acc);
        {
            const int tid = otid(), wid = tid >> 6, wr = wid >> 2, wc = wid & 3;
            const size_t o0 = (size_t)(tm * 256 + wr * 128) * DM + tn * 256 + wc * 64;
#pragma unroll
            for (int mp = 0; mp < 4; ++mp)
                patch_pass(acc, mp, smem, [&](int row, int col, const f32x4 v) {
                    const size_t off = o0 + (size_t)row * DM + col;
                    const f32x4 xv = *(const f32x4*)(x + off);
                    *(f32x4*)(out + off) = xv * DN_ALPHA + v;
                });
        }
    }
}

__device__ void phase5(const Params& p, int c, int part, int nparts) {
    const int tid5 = otid(); const int lane = tid5 & 63, wid = tid5 >> 6;
    float* out = p.out + (size_t)c * CH * DM;
    f32x4 g[4], b[4];
#pragma unroll
    for (int i = 0; i < 4; ++i) { g[i] = *(const f32x4*)(p.ln_g + i * 256 + lane * 4); b[i] = *(const f32x4*)(p.ln_b + i * 256 + lane * 4); }
    for (int row = part * 8 + wid; row < CH; row += nparts * 8) {
        float* rp = out + (size_t)row * DM;
        f32x4 v[4];
#pragma unroll
        for (int i = 0; i < 4; ++i) v[i] = *(const f32x4*)(rp + i * 256 + lane * 4);
        float s = 0.f;
#pragma unroll
        for (int i = 0; i < 4; ++i) s += (v[i][0] + v[i][1]) + (v[i][2] + v[i][3]);
#pragma unroll
        for (int m = 1; m < 64; m <<= 1) s += __shfl_xor(s, m);
        const float mu = s * (1.f / 1024.f);
        float q = 0.f;
#pragma unroll
        for (int i = 0; i < 4; ++i) { const f32x4 d = v[i] - mu; q += (d[0] * d[0] + d[1] * d[1]) + (d[2] * d[2] + d[3] * d[3]); }
#pragma unroll
        for (int m = 1; m < 64; m <<= 1) q += __shfl_xor(q, m);
        const float rstd = rsqrtf(q * (1.f / 1024.f) + 1e-5f);
#pragma unroll
        for (int i = 0; i < 4; ++i) { const f32x4 y = (v[i] - mu) * rstd * g[i] + b[i]; *(f32x4*)(rp + i * 256 + lane * 4) = y; }
    }
}

DEVI void grid_barrier(unsigned* ctr, unsigned target) {
    asm volatile("s_waitcnt vmcnt(0) lgkmcnt(0)" ::: "memory");
    __syncthreads();
    if (threadIdx.x == 0) {
        __builtin_amdgcn_fence(__ATOMIC_RELEASE, "agent");
        asm volatile("s_waitcnt vmcnt(0)" ::: "memory");
        __hip_atomic_fetch_add(ctr, 1u, __ATOMIC_RELAXED, __HIP_MEMORY_SCOPE_AGENT);
        for (unsigned spins = 0; spins < (1u << 22); ++spins) {
            if (__hip_atomic_load(ctr, __ATOMIC_RELAXED, __HIP_MEMORY_SCOPE_AGENT) >= target) break;
            __builtin_amdgcn_s_sleep(1);
        }
        __builtin_amdgcn_fence(__ATOMIC_ACQUIRE, "agent");
        asm volatile("s_waitcnt vmcnt(0)" ::: "memory");
    }
    __syncthreads();
}

__global__ void __launch_bounds__(NTHREADS, 2) mega_fwd(Params p) {
    extern __shared__ __attribute__((aligned(16))) unsigned char smem[];
    cg::grid_group grid = cg::this_grid();
    phase0(p);
    grid.sync();
    unsigned* ctr = (unsigned*)(p.ws + OFF_BAR);
    unsigned target = 0;
    const unsigned nb = gridDim.x;
#pragma unroll 1
    for (int c = 0; c <= NCHUNK; ++c) {
        phase1(p, c, smem);
        if (c == NCHUNK) break;
        target += nb; grid_barrier(ctr, target);
        phase2(p, c, smem);
        target += nb; grid_barrier(ctr, target);
        phase3(p, c, smem);
        phase4(p, c, smem);
        target += nb; grid_barrier(ctr, target);
    }
}

extern "C" void kernel_launch(void* const* d_in, const int* in_sizes, int n_in, void* d_out, int out_size, void* d_ws, size_t ws_size, hipStream_t stream) {
    static int grid_blocks = 0;
    if (!grid_blocks) {
        int dev = 0, cus = 0, per_cu = 0;
        hipGetDevice(&dev);
        hipDeviceGetAttribute(&cus, hipDeviceAttributeMultiprocessorCount, dev);
        hipFuncSetAttribute((const void*)mega_fwd, hipFuncAttributeMaxDynamicSharedMemorySize, SMEM_BYTES);
        hipOccupancyMaxActiveBlocksPerMultiprocessor(&per_cu, (const void*)mega_fwd, NTHREADS, SMEM_BYTES);
        if (per_cu < 1) per_cu = 1;
        if (per_cu > 1) per_cu = 1;
        grid_blocks = cus * per_cu;
    }
    Params p{};
    p.x_prompt = (const float*)d_in[0]; p.x_sample = (const float*)d_in[1]; p.mem_prompt = (const float*)d_in[2]; p.mem_sample = (const float*)d_in[3];
    p.w_in = (const float*)d_in[4]; p.q_norm = (const float*)d_in[5]; p.k_norm = (const float*)d_in[6]; p.rpb = (const float*)d_in[7];
    p.w_mem_kv = (const float*)d_in[8]; p.w_branch = (const float*)d_in[9]; p.w_out = (const float*)d_in[10]; p.ln_g = (const float*)d_in[11]; p.ln_b = (const float*)d_in[12];
    p.out = (float*)d_out;
    p.ws = (unsigned char*)d_ws;
    if (ws_size < WS_END) { fprintf(stderr, "workspace too small\n"); return; }
    (void)hipMemsetAsync((unsigned char*)d_ws + OFF_BAR, 0, 256 + 256 + 2048, stream);
    void* args[] = {&p};
    hipError_t e = hipLaunchCooperativeKernel((void*)mega_fwd, dim3(grid_blocks), dim3(NTHREADS), args, SMEM_BYTES, stream);
    if (e != hipSuccess) fprintf(stderr, "cooperative launch failed: %s (grid %d)\n", hipGetErrorString(e), grid_blocks);
}
```

```cpp
#include <hip/hip_runtime.h>
#include <hip/hip_cooperative_groups.h>
#include <cstdio>
#include <cstdint>
namespace cg = cooperative_groups;

typedef unsigned short bf16_t;
typedef short bf16x8 __attribute__((ext_vector_type(8)));
typedef float f32x4 __attribute__((ext_vector_type(4)));
typedef float f32x16 __attribute__((ext_vector_type(16)));
typedef unsigned u32x4 __attribute__((ext_vector_type(4)));

#define DEVI __device__ __forceinline__

constexpr int NTHREADS = 512;
constexpr int CH = 16384;
constexpr int NCHUNK = 6;
constexpr int LDH = 7424;
constexpr int DM = 1024;
constexpr float LOG2E = 1.4426950408889634f;
constexpr float DN_ALPHA = 1.189207115002721f;
constexpr int SMEM_BYTES = 131072;

constexpr int C_QA = 0, C_KA = 512, C_VA = 640, C_ZA = 768, C_QB = 1280, C_KB = 1792, C_VB = 2304, C_ZB = 2816, C_QM = 3328, C_ZM = 3840, C_G = 4352;

struct Params {
    const float *x_prompt, *x_sample, *mem_prompt, *mem_sample, *w_in, *q_norm, *k_norm, *rpb, *w_mem_kv, *w_branch, *w_out, *ln_g, *ln_b;
    float* out;
    unsigned char* ws;
};
constexpr size_t al256(size_t x) { return (x + 255) & ~(size_t)255; }
constexpr size_t OFF_XB = 0;
constexpr size_t OFF_H = OFF_XB + al256((size_t)98304 * 1024 * 2);
constexpr size_t OFF_VAT = OFF_H + al256((size_t)CH * LDH * 2);
constexpr size_t OFF_VBT = OFF_VAT + 6 * al256((size_t)128 * CH * 2);
constexpr size_t OFF_MERGED = OFF_VBT + 6 * al256((size_t)512 * CH * 2);
constexpr size_t OFF_WT = OFF_MERGED + 6 * al256((size_t)CH * DM * 2);
constexpr size_t OFF_WBT = OFF_WT + al256((size_t)LDH * 1024 * 2);
constexpr size_t OFF_WOT = OFF_WBT + al256((size_t)3 * 1024 * 512 * 2);
constexpr size_t OFF_WKVT = OFF_WOT + al256((size_t)1024 * 1024 * 2);
constexpr size_t OFF_MEMB = OFF_WKVT + al256((size_t)1024 * 1024 * 2);
constexpr size_t OFF_KVM = OFF_MEMB + al256((size_t)2560 * 1024 * 2);
constexpr size_t OFF_VMT = OFF_KVM + al256((size_t)2560 * 512 * 2);
constexpr size_t OFF_ROPE = OFF_VMT + al256((size_t)10 * 512 * 256 * 2);
constexpr size_t OFF_KA = OFF_ROPE + al256((size_t)256 * 16 * 2 * 4);
constexpr size_t OFF_BAR = OFF_KA + 6 * al256((size_t)2 * CH * 64 * 2);
constexpr size_t OFF_MISC = OFF_BAR + 256;
constexpr size_t OFF_PANEL = OFF_MISC + 256;
constexpr size_t WS_END = OFF_PANEL + 2048;
#define WS_XB(p) ((bf16_t*)((p).ws + OFF_XB))
#define WS_H(p) ((bf16_t*)((p).ws + OFF_H))
#define WS_VAT(p) ((bf16_t*)((p).ws + OFF_VAT + (size_t)c * (128 * CH * 2)))
#define WS_VBT(p) ((bf16_t*)((p).ws + OFF_VBT + (size_t)c * (512 * CH * 2)))
#define WS_MERGED(p) ((bf16_t*)((p).ws + OFF_MERGED + (size_t)c * (CH * DM * 2)))
#define WS_WT(p) ((bf16_t*)((p).ws + OFF_WT))
#define WS_WBT(p) ((bf16_t*)((p).ws + OFF_WBT))
#define WS_WOT(p) ((bf16_t*)((p).ws + OFF_WOT))
#define WS_WKVT(p) ((bf16_t*)((p).ws + OFF_WKVT))
#define WS_MEMB(p) ((bf16_t*)((p).ws + OFF_MEMB))
#define WS_KVM(p) ((bf16_t*)((p).ws + OFF_KVM))
#define WS_VMT(p) ((bf16_t*)((p).ws + OFF_VMT))
#define WS_ROPE(p) ((float*)((p).ws + OFF_ROPE))
#define WS_KA(p) ((bf16_t*)((p).ws + OFF_KA + (size_t)c * (2 * CH * 64 * 2)))

typedef float f32x2 __attribute__((ext_vector_type(2)));
typedef __bf16 bf16x2n __attribute__((ext_vector_type(2)));
DEVI unsigned pk_bf16(float lo, float hi) { const f32x2 v = {lo, hi}; return __builtin_bit_cast(unsigned, __builtin_convertvector(v, bf16x2n)); }
DEVI bf16_t to_bf16(float f) { return (bf16_t)(pk_bf16(f, 0.f) & 0xffffu); }
DEVI float bf2f(bf16_t v) { return __uint_as_float(((unsigned)v) << 16); }
DEVI float fast_exp2(float x) { return __builtin_amdgcn_exp2f(x); }
DEVI float fast_rcp(float x) { return __builtin_amdgcn_rcpf(x); }
DEVI float sigmoidf_(float x) { return fast_rcp(1.f + fast_exp2(-x * LOG2E)); }
DEVI float siluf_(float x) { return x * sigmoidf_(x); }
DEVI int otid() { int t = threadIdx.x; asm volatile("" : "+v"(t)); return t; }
DEVI int obid() { int b = blockIdx.x; asm volatile("" : "+s"(b)); return b; }

typedef __attribute__((address_space(3))) unsigned char lds_u8;
typedef __attribute__((address_space(3))) unsigned lds_u32;
DEVI void glds16(const void* g, unsigned lds_off) {
    unsigned sv;
    asm volatile("s_mov_b32 %0, m0\n\ts_mov_b32 m0, %2\n\ts_nop 0\n\tglobal_load_lds_dwordx4 %1, off\n\ts_mov_b32 m0, %0" : "=&s"(sv) : "v"(g), "s"(__builtin_amdgcn_readfirstlane(lds_off)) : "memory");
}


DEVI void transpose_cvt(const float* __restrict__ src, bf16_t* __restrict__ dst, int K, int N, size_t gtid, size_t gsz) {
    const size_t total = (size_t)(K / 8) * N;
    for (size_t i = gtid; i < total; i += gsz) {
        const int n = (int)(i % N); const int k8 = (int)(i / N);
        const float* s = src + (size_t)k8 * 8 * N + n;
        float v0 = s[0], v1 = s[(size_t)N], v2 = s[(size_t)2 * N], v3 = s[(size_t)3 * N], v4 = s[(size_t)4 * N], v5 = s[(size_t)5 * N], v6 = s[(size_t)6 * N], v7 = s[(size_t)7 * N];
        uint4 o; o.x = pk_bf16(v0, v1); o.y = pk_bf16(v2, v3); o.z = pk_bf16(v4, v5); o.w = pk_bf16(v6, v7);
        *(uint4*)(dst + (size_t)n * K + k8 * 8) = o;
    }
}

DEVI void cvt_rows(const float* __restrict__ src, bf16_t* __restrict__ dst, size_t ngroups8, size_t gtid, size_t gsz) {
    for (size_t i = gtid; i < ngroups8; i += gsz) {
        const float4 a = ((const float4*)src)[i * 2], b = ((const float4*)src)[i * 2 + 1];
        uint4 o; o.x = pk_bf16(a.x, a.y); o.y = pk_bf16(a.z, a.w); o.z = pk_bf16(b.x, b.y); o.w = pk_bf16(b.z, b.w);
        ((uint4*)dst)[i] = o;
    }
}

__device__ void phase0(const Params& p) {
    const size_t gtid = (size_t)blockIdx.x * NTHREADS + threadIdx.x, gsz = (size_t)gridDim.x * NTHREADS;
    cvt_rows(p.x_prompt, WS_XB(p), (size_t)CH * 128, gtid, gsz);
    cvt_rows(p.mem_prompt, WS_MEMB(p), (size_t)512 * 128, gtid, gsz);
    cvt_rows(p.mem_sample, WS_MEMB(p) + (size_t)512 * 1024, (size_t)2048 * 128, gtid, gsz);
    transpose_cvt(p.w_in, WS_WT(p), 1024, LDH, gtid, gsz);
    transpose_cvt(p.w_mem_kv, WS_WKVT(p), 1024, 1024, gtid, gsz);
    transpose_cvt(p.w_out, WS_WOT(p), 1024, 1024, gtid, gsz);
    for (int n = 0; n < 3; ++n) transpose_cvt(p.w_branch + (size_t)n * 512 * 1024, WS_WBT(p) + (size_t)n * 1024 * 512, 512, 1024, gtid, gsz);
    if (gtid == 0) {
        float mq = 0.f, mk = 0.f;
        for (int i = 0; i < 64; ++i) { mq = fmaxf(mq, fabsf(p.q_norm[i])); mk = fmaxf(mk, fabsf(p.k_norm[i])); }
        ((float*)(p.ws + OFF_MISC))[0] = 8.f * mq * mk * LOG2E * 1.02f;
    }
    for (size_t i = gtid; i < 256 * 16; i += gsz) {
        const int pos = (int)(i >> 4), f = (int)(i & 15);
        const float inv = exp2f(-(float)f * (13.287712379549449f / 16.f));
        const float ang = (float)pos * inv;
        const double kd = rint((double)ang * 0.15915494309189535);
        const double r = (double)ang - kd * 6.283185307179586;
        const double r2 = r * r;
        double sn = r, cs = 1.0;
        {
            double ts = r, tc = 1.0;
#pragma unroll 1
            for (int n = 1; n <= 14; ++n) {
                tc = -tc * r2 / (double)((2 * n - 1) * (2 * n));
                ts = -ts * r2 / (double)((2 * n) * (2 * n + 1));
                cs += tc; sn += ts;
            }
        }
        WS_ROPE(p)[i * 2] = (float)cs; WS_ROPE(p)[i * 2 + 1] = (float)sn;
    }
}

DEVI void gemm_mainloop(const bf16_t* __restrict__ A, int lda, const bf16_t* __restrict__ Bt, int ldb, int K, unsigned char* smem, f32x4 (&acc)[8][4]) {
    constexpr int TB = 256 * 128;
    const int tid = otid(), lane = tid & 63, wid = tid >> 6, wr = wid >> 2, wc = wid & 3;
    const unsigned lds = (unsigned)(size_t)((lds_u8*)smem);
    unsigned goa[4], gob[4];
#pragma unroll
    for (int i = 0; i < 4; ++i) {
        const int row = 8 * (wid * 4 + i) + (lane >> 3);
        const int c = (lane & 7) ^ ((row >> 1) & 7);
        goa[i] = (unsigned)(row * lda + c * 8) * 2u; gob[i] = (unsigned)(row * ldb + c * 8) * 2u;
    }
    const unsigned ldsw = lds + wid * 4096;
    __syncthreads();
#define GM_ISSUE(k0_, st_) do { _Pragma("unroll") for (int i_ = 0; i_ < 4; ++i_) { glds16((const char*)A + goa[i_] + (k0_) * 2, ldsw + (st_) * (2 * TB) + i_ * 1024); glds16((const char*)Bt + gob[i_] + (k0_) * 2, ldsw + (st_) * (2 * TB) + TB + i_ * 1024); } } while (0)
#define GM_LOAD(a_, b_, sb_, xo_) do { _Pragma("unroll") for (int n_ = 0; n_ < 4; ++n_) b_[n_] = *(const bf16x8*)((sb_) + boff + n_ * 2048 + (xo_)); \
        _Pragma("unroll") for (int m_ = 0; m_ < 8; ++m_) a_[m_] = *(const bf16x8*)((sb_) + aoff + m_ * 2048 + (xo_)); } while (0)
#define GM_MMA(a_, b_) do { _Pragma("unroll") for (int m_ = 0; m_ < 8; ++m_) _Pragma("unroll") for (int n_ = 0; n_ < 4; ++n_) \
        acc[m_][n_] = __builtin_amdgcn_mfma_f32_16x16x32_bf16(a_[m_], b_[n_], acc[m_][n_], 0, 0, 0); } while (0)
    const int fr = lane & 15, fq = lane >> 4;
    const int x0 = (fq ^ ((fr >> 1) & 7)) << 4, x1 = x0 ^ 64;
    const int aoff = (wr * 128 + fr) * 128, boff = TB + (wc * 64 + fr) * 128;
    bf16x8 a0[8], b0[4], a1[8], b1[4];
    const int nk = K >> 6;
    GM_ISSUE(0, 0);
    asm volatile("s_waitcnt vmcnt(0) lgkmcnt(0)" ::: "memory");
    __builtin_amdgcn_s_barrier();
    asm volatile("" ::: "memory");
    GM_ISSUE(64, 1);
    GM_LOAD(a0, b0, smem, x0);
    GM_LOAD(a1, b1, smem, x1);
    GM_MMA(a0, b0);
#pragma unroll 1
    for (int kt = 1; kt < nk; ++kt) {
        asm volatile("s_waitcnt vmcnt(0) lgkmcnt(0)" ::: "memory");
        __builtin_amdgcn_s_barrier();
        asm volatile("" ::: "memory");
        if (kt + 1 < nk) GM_ISSUE((kt + 1) * 64, (kt + 1) & 1);
        const unsigned char* sb = smem + (kt & 1) * (2 * TB);
        GM_LOAD(a0, b0, sb, x0);
        GM_MMA(a1, b1);
        GM_LOAD(a1, b1, sb, x1);
        GM_MMA(a0, b0);
    }
    GM_MMA(a1, b1);
#undef GM_ISSUE
#undef GM_LOAD
#undef GM_MMA
    asm volatile("s_waitcnt lgkmcnt(0)" ::: "memory");
    __syncthreads();
}

DEVI void zero_acc(f32x4 (&acc)[8][4]) {
#pragma unroll
    for (int i = 0; i < 8; ++i)
#pragma unroll
        for (int j = 0; j < 4; ++j) acc[i][j] = (f32x4){0.f, 0.f, 0.f, 0.f};
}

DEVI void wave_coords(int m0, int n0, int& rbase, int& cbase, int& ncol) {
    const int tid = otid(), lane = tid & 63, wid = tid >> 6, wr = wid >> 2, wc = wid & 3;
    rbase = m0 + wr * 128 + (lane >> 4) * 4; ncol = n0 + wc * 64; cbase = ncol + (lane & 15);
}

template <class F>
DEVI void patch_pass(const f32x4 (&acc)[8][4], int mp, unsigned char* smem, F f) {
    const int t = otid(), lane = t & 63;
    float* patch = (float*)(smem + (t >> 6) * 8704);
#pragma unroll
    for (int m2 = 0; m2 < 2; ++m2)
#pragma unroll
        for (int ni = 0; ni < 4; ++ni)
#pragma unroll
            for (int r = 0; r < 4; ++r) patch[(m2 * 16 + (lane >> 4) * 4 + r) * 68 + ni * 16 + (lane & 15)] = acc[mp * 2 + m2][ni][r];
#pragma unroll
    for (int it = 0; it < 8; ++it) {
        const int row = it * 4 + (lane >> 4), col = (lane & 15) * 4;
        const f32x4 v = *(const f32x4*)(patch + row * 68 + col);
        f(mp * 32 + row, col, v);
    }
    __builtin_amdgcn_sched_barrier(0);
}
DEVI uint2 pack4(const f32x4 v) { uint2 w; w.x = pk_bf16(v[0], v[1]); w.y = pk_bf16(v[2], v[3]); return w; }
DEVI f32x4 unpack4(const uint2 w) { f32x4 v; v[0] = __uint_as_float(w.x << 16); v[1] = __uint_as_float(w.x & 0xffff0000u); v[2] = __uint_as_float(w.y << 16); v[3] = __uint_as_float(w.y & 0xffff0000u); return v; }

DEVI int remap_id(int id, int G) {
    if (G & 7) return id;
    const int rnd = id / G, b = id - rnd * G;
    return rnd * G + (b & 7) * (G >> 3) + (b >> 3);
}

DEVI void gemm1_epilogue(const Params& p, f32x4 (&acc)[8][4], int m0, int n0, int seqS, int c, unsigned char* smem) {
    const int tid = otid(), lane = tid & 63, wid = tid >> 6, wr = wid >> 2, wc = wid & 3;
    const int rw = m0 + wr * 128, ncol = n0 + wc * 64;
    bf16_t* H = WS_H(p);
    if (ncol >= C_VA && (ncol < C_ZA || (ncol >= C_VB && ncol < C_ZB))) {
        bf16_t* Vt = (ncol < C_ZA) ? WS_VAT(p) : WS_VBT(p);
        const int c0 = (ncol < C_ZA) ? C_VA : C_VB;
        const int rbase = rw + (lane >> 4) * 4, cbase = ncol + (lane & 15);
#pragma unroll
        for (int mi = 0; mi < 8; ++mi)
#pragma unroll
            for (int ni = 0; ni < 4; ++ni) {
                uint2 w; w.x = pk_bf16(acc[mi][ni][0], acc[mi][ni][1]); w.y = pk_bf16(acc[mi][ni][2], acc[mi][ni][3]);
                *(uint2*)(Vt + (size_t)(cbase + ni * 16 - c0) * CH + rbase + mi * 16) = w;
            }
        return;
    }
    if (ncol < C_VA) {
        const bool isq = ncol < C_KA;
        const float* g = isq ? p.q_norm : p.k_norm;
        float gv[4];
#pragma unroll
        for (int ni = 0; ni < 4; ++ni) gv[ni] = g[ni * 16 + (lane & 15)];
        const float sc = isq ? 0.125f * LOG2E : 1.f;
        const float2* rope = (const float2*)WS_ROPE(p);
        const int rbase = rw + (lane >> 4) * 4;
        bf16_t* dst = isq ? H + ncol + (lane & 15) : WS_KA(p) + (size_t)((ncol - C_KA) >> 6) * CH * 64 + (lane & 15);
        const int ldd = isq ? LDH : 64;
#pragma unroll
        for (int mi = 0; mi < 8; ++mi)
#pragma unroll
            for (int r = 0; r < 4; ++r) {
                float x0 = acc[mi][0][r], x1 = acc[mi][1][r], x2 = acc[mi][2][r], x3 = acc[mi][3][r];
                float ss = x0 * x0 + x1 * x1 + x2 * x2 + x3 * x3;
                ss += __shfl_xor(ss, 1); ss += __shfl_xor(ss, 2); ss += __shfl_xor(ss, 4); ss += __shfl_xor(ss, 8);
                const float rs = rsqrtf(ss * (1.f / 64.f) + 1e-6f);
                x0 *= rs * gv[0]; x1 *= rs * gv[1]; x2 *= rs * gv[2]; x3 *= rs * gv[3];
                const int row = rbase + mi * 16 + r;
                const int t = row & (seqS - 1);
                const float2 cr = rope[(t >> 6) * 16 + (lane & 15)], cc = rope[(t & 63) * 16 + (lane & 15)];
                const float y0 = x0 * cr.x - x1 * cr.y, y1 = x1 * cr.x + x0 * cr.y;
                const float y2 = x2 * cc.x - x3 * cc.y, y3 = x3 * cc.x + x2 * cc.y;
                bf16_t* o = dst + (size_t)row * ldd;
                o[0] = to_bf16(y0 * sc); o[16] = to_bf16(y1 * sc); o[32] = to_bf16(y2 * sc); o[48] = to_bf16(y3 * sc);
            }
        return;
    }
    int mode; float scale = 1.f;
    if (ncol >= C_G) mode = 3;
    else if (ncol >= C_ZM) mode = 2;
    else if (ncol >= C_QM) { mode = 0; scale = 0.08838834764831845f * LOG2E; }
    else if (ncol >= C_ZB) mode = 2;
    else if (ncol >= C_KB) mode = 0;
    else if (ncol >= C_QB) { mode = 0; scale = 0.125f * LOG2E; }
    else mode = 2;
    bf16_t* dst = H + (size_t)rw * LDH + ncol;
#pragma unroll
    for (int mp = 0; mp < 4; ++mp)
        patch_pass(acc, mp, smem, [&](int row, int col, f32x4 v) {
            if (mode == 0) { v = v * scale; }
            else if (mode == 2) {
#pragma unroll
                for (int k = 0; k < 4; ++k) v[k] = siluf_(v[k]);
            } else {
#pragma unroll
                for (int k = 0; k < 4; ++k) v[k] = sigmoidf_(v[k]);
            }
            *(uint2*)(dst + (size_t)row * LDH + col) = pack4(v);
        });
}

__device__ void phase5(const Params& p, int c, int part, int nparts);
__device__ void phase1(const Params& p, int c, unsigned char* smem) {
    const int G = gridDim.x;
    const int nN = LDH / 256;
    const int ntile = c == NCHUNK ? 0 : 64 * nN + (c == 0 ? 40 : 0);
    const int nround = ntile / G + 1;
    const int seqS = c < 2 ? 16384 : 8192;
    const bf16_t* xb = WS_XB(p) + (size_t)c * CH * DM;
    for (int id = obid(); id < nround * G; id += G) {
        const int v = remap_id(id, G);
        if (v >= ntile) {
            if (c > 0) phase5(p, c - 1, v - ntile, nround * G - ntile);
            if (c + 1 < NCHUNK) {
                const int cn = c + 1;
                const float* xs = cn < 2 ? p.x_prompt + (size_t)cn * CH * DM : p.x_sample + (size_t)(cn - 2) * CH * DM;
                cvt_rows(xs, WS_XB(p) + (size_t)cn * CH * DM, (size_t)CH * DM / 8, (size_t)(v - ntile) * NTHREADS + threadIdx.x, (size_t)(nround * G - ntile) * NTHREADS);
            }
            continue;
        }
        f32x4 acc[8][4];
        zero_acc(acc);
        int rbase, cbase, ncol;
        if (v < 64 * nN) {
            const int g = v / (8 * nN), r = v - g * 8 * nN;
            const int tm = g * 8 + (r & 7), tn = r >> 3;
            gemm_mainloop(xb + (size_t)tm * 256 * DM, DM, WS_WT(p) + (size_t)tn * 256 * DM, DM, DM, smem, acc);
            gemm1_epilogue(p, acc, tm * 256, tn * 256, seqS, c, smem);
        } else {
            const int v2 = v - 64 * nN;
            const int tm = v2 % 10, tn = v2 / 10;
            gemm_mainloop(WS_MEMB(p) + (size_t)tm * 256 * DM, DM, WS_WKVT(p) + (size_t)tn * 256 * DM, DM, DM, smem, acc);
            wave_coords(tm * 256, tn * 256, rbase, cbase, ncol);
#pragma unroll
            for (int mi = 0; mi < 8; ++mi)
#pragma unroll
                for (int ni = 0; ni < 4; ++ni) {
                    const int row = rbase + mi * 16, col = cbase + ni * 16;
                    if (ncol < 512) {
#pragma unroll
                        for (int r = 0; r < 4; ++r) WS_KVM(p)[(size_t)(row + r) * 512 + col] = to_bf16(acc[mi][ni][r]);
                    } else {
                        uint2 w; w.x = pk_bf16(acc[mi][ni][0], acc[mi][ni][1]); w.y = pk_bf16(acc[mi][ni][2], acc[mi][ni][3]);
                        const int sq = row >> 8, mm = row & 255;
                        *(uint2*)(WS_VMT(p) + ((size_t)sq * 512 + (col - 512)) * 256 + mm) = w;
                    }
                }
        }
    }
}

struct NaInfo { int krow0; int qrow; int q_wr; const float* bias; };

template <int D, int MODE>
DEVI void attn_block(const bf16_t* Q, int ldq, const bf16_t* __restrict__ Kp, int ldk, const bf16_t* __restrict__ Vt, int ldv, int nkt,
                     const bf16_t* Z, int ldz, bf16_t* O, int ldo, unsigned char* smem, const NaInfo na) {
    constexpr int KSTR = (D + 8) * 2;
    constexpr int KBYTES = 64 * KSTR;
    constexpr int VBYTES = D * 144;
    constexpr int STAGE = KBYTES + VBYTES;
    constexpr int NP = D * 8 / NTHREADS;
    constexpr int KPR = D / 8;
    constexpr bool PF = (D == 64);
    const int tid = otid(), lane = tid & 63, wid = tid >> 6;
    const int r31 = lane & 31, h = lane >> 5;
    bf16x8 qf[D / 16];
    {
        const bf16_t* qp = Q + (size_t)(wid * 32 + r31) * ldq + h * 8;
#pragma unroll
        for (int kk = 0; kk < D / 16; ++kk) qf[kk] = *(const bf16x8*)(qp + kk * 16);
    }
    f32x16 o[D / 32];
#pragma unroll
    for (int i = 0; i < D / 32; ++i)
#pragma unroll
        for (int j = 0; j < 16; ++j) o[i][j] = 0.f;
    float m_run = -1e30f, l_run = 0.f;
    u32x4 rk[NP], rv[NP];
    int kgo[NP], kso[NP], vgo[NP], vso[NP];
#pragma unroll
    for (int i = 0; i < NP; ++i) {
        const int pc = tid + NTHREADS * i;
        const int krow = pc / KPR, kc = pc % KPR;
        kgo[i] = krow * ldk + kc * 8; kso[i] = krow * KSTR + kc * 16;
        const int vrow = pc >> 3, vc = pc & 7;
        vgo[i] = vrow * ldv + vc * 8; vso[i] = KBYTES + vrow * 144 + vc * 16;
    }
#pragma unroll
    for (int i = 0; i < NP; ++i) { rk[i] = *(const u32x4*)(Kp + kgo[i]); rv[i] = *(const u32x4*)(Vt + vgo[i]); }
#pragma unroll
    for (int i = 0; i < NP; ++i) { *(u32x4*)(smem + kso[i]) = rk[i]; *(u32x4*)(smem + vso[i]) = rv[i]; }
    __syncthreads();
    const int pr = (r31 & 0x13) | ((r31 & 4) << 1) | ((r31 & 8) >> 1);
    const int kroff = pr * KSTR + h * 16;
    const int vroff = KBYTES + r31 * 144 + h * 16;
    int qcol = 0, q_wc = 0;
    if (MODE == 1) { qcol = (wid & 1) * 32 + r31; q_wc = min(max(qcol - 8, 0), 48); }
#pragma unroll 1
    for (int kt = 0; kt < nkt; ++kt) {
        const int buf = kt & 1;
        if (PF && kt + 1 < nkt) {
            const bf16_t* kn = Kp + (size_t)(kt + 1) * 64 * ldk;
            const bf16_t* vn = Vt + (kt + 1) * 64;
#pragma unroll
            for (int i = 0; i < NP; ++i) { rk[i] = *(const u32x4*)(kn + kgo[i]); rv[i] = *(const u32x4*)(vn + vgo[i]); }
        }
        bool need = true;
        int krow = 0;
        if (MODE == 1) { krow = na.krow0 + kt; need = (krow >= na.q_wr) && (krow < na.q_wr + 8); }
        if (need) {
            const unsigned char* sb = smem + buf * STAGE;
            f32x16 s[2];
#pragma unroll
            for (int kh = 0; kh < 2; ++kh) {
#pragma unroll
                for (int j = 0; j < 16; ++j) s[kh][j] = 0.f;
#pragma unroll
                for (int kk = 0; kk < D / 16; ++kk) {
                    const bf16x8 a = *(const bf16x8*)(sb + kroff + kh * 32 * KSTR + kk * 32);
                    s[kh] = __builtin_amdgcn_mfma_f32_32x32x16_bf16(a, qf[kk], s[kh], 0, 0, 0);
                }
            }
            if (MODE == 1) {
                const float* brow = na.bias + (krow - na.qrow + 7) * 128 + 48 + 15 + 8 * h - qcol;
                const int mb = 8 * h - q_wc;
#pragma unroll
                for (int kh = 0; kh < 2; ++kh)
#pragma unroll
                    for (int j = 0; j < 16; ++j) {
                        const int c0 = kh * 32 + 16 * (j >> 3) + (j & 7);
                        const float bv = brow[c0];
                        const bool ok = (unsigned)(c0 + mb) < 16u;
                        s[kh][j] = ok ? s[kh][j] + bv : -1e30f;
                    }
            }
            float mx = s[0][0];
#pragma unroll
            for (int j = 1; j < 16; ++j) mx = fmaxf(mx, s[0][j]);
#pragma unroll
            for (int j = 0; j < 16; ++j) mx = fmaxf(mx, s[1][j]);
            mx = fmaxf(mx, __shfl_xor(mx, 32));
            const float m_new = fmaxf(m_run, mx);
            const float alpha = fast_exp2(m_run - m_new);
            m_run = m_new;
            float ls = 0.f;
            bf16x8 pf[2][2];
#pragma unroll
            for (int kh = 0; kh < 2; ++kh)
#pragma unroll
                for (int sp = 0; sp < 2; ++sp) {
                    float e[8];
#pragma unroll
                    for (int j = 0; j < 8; ++j) { e[j] = fast_exp2(s[kh][sp * 8 + j] - m_new); ls += e[j]; }
                    u32x4 cv; cv.x = pk_bf16(e[0], e[1]); cv.y = pk_bf16(e[2], e[3]); cv.z = pk_bf16(e[4], e[5]); cv.w = pk_bf16(e[6], e[7]);
                    pf[kh][sp] = __builtin_bit_cast(bf16x8, cv);
                }
            l_run = l_run * alpha + ls;
#pragma unroll
            for (int dh = 0; dh < D / 32; ++dh) {
#pragma unroll
                for (int j = 0; j < 16; ++j) o[dh][j] *= alpha;
#pragma unroll
                for (int kh = 0; kh < 2; ++kh)
#pragma unroll
                    for (int sp = 0; sp < 2; ++sp) {
                        const bf16x8 a = *(const bf16x8*)(sb + vroff + dh * 32 * 144 + (kh * 32 + sp * 16) * 2);
                        o[dh] = __builtin_amdgcn_mfma_f32_32x32x16_bf16(a, pf[kh][sp], o[dh], 0, 0, 0);
                    }
            }
        }
        if (kt + 1 < nkt) {
            if (!PF) {
                const bf16_t* kn = Kp + (size_t)(kt + 1) * 64 * ldk;
                const bf16_t* vn = Vt + (kt + 1) * 64;
#pragma unroll
                for (int i = 0; i < NP; ++i) { rk[i] = *(const u32x4*)(kn + kgo[i]); rv[i] = *(const u32x4*)(vn + vgo[i]); }
            }
            unsigned char* nb = smem + (buf ^ 1) * STAGE;
#pragma unroll
            for (int i = 0; i < NP; ++i) { *(u32x4*)(nb + kso[i]) = rk[i]; *(u32x4*)(nb + vso[i]) = rv[i]; }
        }
        __syncthreads();
    }
    const float lt = l_run + __shfl_xor(l_run, 32);
    const float inv = 1.f / lt;
    const bf16_t* zp = Z + (size_t)(wid * 32 + r31) * ldz;
    bf16_t* op = O + (size_t)(wid * 32 + r31) * ldo;
#pragma unroll
    for (int dh = 0; dh < D / 32; ++dh)
#pragma unroll
        for (int g = 0; g < 4; ++g) {
            const int d0 = dh * 32 + 8 * g + 4 * h;
            const uint2 zz = *(const uint2*)(zp + d0);
            const float z0 = __uint_as_float(zz.x << 16), z1 = __uint_as_float(zz.x & 0xffff0000u), z2 = __uint_as_float(zz.y << 16), z3 = __uint_as_float(zz.y & 0xffff0000u);
            uint2 w;
            w.x = pk_bf16(o[dh][g * 4 + 0] * inv * z0, o[dh][g * 4 + 1] * inv * z1);
            w.y = pk_bf16(o[dh][g * 4 + 2] * inv * z2, o[dh][g * 4 + 3] * inv * z3);
            *(uint2*)(op + d0) = w;
        }
}

template <int MODE, int NH, bool BND>
DEVI void attn64(const bf16_t* Q, int ldq, const bf16_t* __restrict__ Kp, int ldk, const bf16_t* __restrict__ Vt, int ldv, int nkt,
                 const bf16_t* Z, int ldz, bf16_t* O, int ldo, unsigned char* smem, const NaInfo na, const float sbound = 0.f) {
    constexpr int STAGE = 16384;
    const int tid = otid(), lane = tid & 63, wid = tid >> 6;
    const int r31 = lane & 31, h = lane >> 5;
    const unsigned lds = (unsigned)(size_t)((lds_u8*)smem);
    bf16x8 qf[NH][4];
    {
        const bf16_t* qp = Q + (size_t)(wid * 32 + r31) * ldq + h * 8;
#pragma unroll
        for (int hh = 0; hh < NH; ++hh)
#pragma unroll
            for (int kk = 0; kk < 4; ++kk) qf[hh][kk] = *(const bf16x8*)(qp + hh * 64 + kk * 16);
#pragma unroll
        for (int hh = 0; hh < NH; ++hh)
#pragma unroll
            for (int kk = 0; kk < 4; ++kk) asm volatile("" : "+v"(qf[hh][kk]));
    }
    f32x16 o[NH][2];
    float m_run[NH], l_run[NH];
#pragma unroll
    for (int hh = 0; hh < NH; ++hh) {
        m_run[hh] = -1e30f; l_run[hh] = 0.f;
#pragma unroll
        for (int i = 0; i < 2; ++i)
#pragma unroll
            for (int j = 0; j < 16; ++j) o[hh][i][j] = 0.f;
    }
    int kgo, vgo;
    {
        const int row = 8 * wid + (lane >> 3);
        const int c = (lane & 7) ^ ((row >> 1) & 7);
        kgo = row * ldk + c * 8; vgo = row * ldv + c * 8;
    }
    const int ldsw = wid * 1024;
#define ATT_ISSUE(kt_, st_) do { const bf16_t* kb_ = Kp + (size_t)(kt_) * 64 * ldk; const bf16_t* vb_ = Vt + (kt_) * 64; \
        glds16(kb_ + kgo, lds + (st_) * STAGE + ldsw); glds16(vb_ + vgo, lds + (st_) * STAGE + 8192 + ldsw); } while (0)
    constexpr int NSUB = (MODE == 0) ? 4 : 1;
    constexpr int RMASK = (MODE == 0) ? 7 : 3;
    if (NSUB > 1) {
#pragma unroll
        for (int s_ = 0; s_ < NSUB; ++s_) ATT_ISSUE(s_, s_);
    } else {
        ATT_ISSUE(0, 0);
        if (nkt > 1) ATT_ISSUE(1, 1);
        if (nkt > 2) ATT_ISSUE(2, 2);
    }
    const int pr = (r31 & 0x13) | ((r31 & 4) << 1) | ((r31 & 8) >> 1);
    const int kbase = pr * 128, kx = h ^ ((pr >> 1) & 7);
    const int vbase = 8192 + r31 * 128, vx = h ^ ((r31 >> 1) & 7);
    int koff[4], voff[4];
#pragma unroll
    for (int i = 0; i < 4; ++i) { koff[i] = kbase + (((2 * i) ^ kx) << 4); voff[i] = vbase + (((2 * i) ^ vx) << 4); }
    f32x16 negm;
#pragma unroll
    for (int j = 0; j < 16; ++j) negm[j] = BND ? -sbound : 0.f;
    int qcol = 0, q_wc = 0;
    if (MODE == 1) { qcol = (wid & 1) * 32 + r31; q_wc = min(max(qcol - 8, 0), 48); }
    int st = 0;
#pragma unroll 1
    for (int kt = 0; kt < nkt; kt += NSUB) {
        if (NSUB > 1) asm volatile("s_waitcnt vmcnt(0)" ::: "memory");
        else if (kt + 2 < nkt) asm volatile("s_waitcnt vmcnt(4)" ::: "memory");
        else if (kt + 1 < nkt) asm volatile("s_waitcnt vmcnt(2)" ::: "memory");
        else asm volatile("s_waitcnt vmcnt(0)" ::: "memory");
        __builtin_amdgcn_s_barrier();
        asm volatile("" ::: "memory");
        if (NSUB > 1) {
            if (kt + NSUB < nkt) {
#pragma unroll
                for (int s_ = 0; s_ < NSUB; ++s_) { const int sn_ = (st + NSUB + s_) & RMASK; ATT_ISSUE(kt + NSUB + s_, sn_); }
            }
        } else if (kt + 3 < nkt) { const int st3 = (st + 3) & 3; ATT_ISSUE(kt + 3, st3); }
#pragma unroll 1
      for (int sub = 0; sub < NSUB; ++sub) {
        bool need = true;
        int krow = 0;
        if (MODE == 1) { krow = na.krow0 + kt; need = (krow >= na.q_wr) && (krow < na.q_wr + 8); }
        if (need) {
            const unsigned char* sb = smem + ((st + sub) & RMASK) * STAGE;
            f32x16 s[NH][2];
#pragma unroll
            for (int kh = 0; kh < 2; ++kh) {
#pragma unroll
                for (int hh = 0; hh < NH; ++hh) s[hh][kh] = negm;
#pragma unroll
                for (int kk = 0; kk < 4; ++kk) {
                    const bf16x8 a = *(const bf16x8*)(sb + koff[kk] + kh * 4096);
#pragma unroll
                    for (int hh = 0; hh < NH; ++hh) s[hh][kh] = __builtin_amdgcn_mfma_f32_32x32x16_bf16(a, qf[hh][kk], s[hh][kh], 0, 0, 0);
                }
            }
            bf16x8 pf[NH][2][2];
#pragma unroll
          for (int hh = 0; hh < NH; ++hh) {
            if (MODE == 1) {
                typedef __attribute__((address_space(3))) float lds_f32;
                const volatile lds_f32* brow = (const volatile lds_f32*)((lds_u8*)smem + 4 * 16384) + (krow - na.qrow + 7) * 128 + 48 + 15 + 8 * h - qcol;
                const int mb = 8 * h - q_wc;
#pragma unroll
                for (int kh = 0; kh < 2; ++kh)
#pragma unroll
                    for (int j = 0; j < 16; ++j) {
                        const int c0 = kh * 32 + 16 * (j >> 3) + (j & 7);
                        const float bv = brow[c0];
                        const bool ok = (unsigned)(c0 + mb) < 16u;
                        s[hh][kh][j] = ok ? s[hh][kh][j] + bv : -1e30f;
                    }
            }
            if (BND) {
                float ls = 0.f;
#pragma unroll
                for (int kh = 0; kh < 2; ++kh)
#pragma unroll
                    for (int sp = 0; sp < 2; ++sp) {
                        float e[8];
#pragma unroll
                        for (int j = 0; j < 8; ++j) { e[j] = fast_exp2(s[hh][kh][sp * 8 + j]); ls += e[j]; }
                        u32x4 cv; cv.x = pk_bf16(e[0], e[1]); cv.y = pk_bf16(e[2], e[3]); cv.z = pk_bf16(e[4], e[5]); cv.w = pk_bf16(e[6], e[7]);
                        pf[hh][kh][sp] = __builtin_bit_cast(bf16x8, cv);
                    }
                l_run[hh] += ls;
            } else {
                float mx = s[hh][0][0];
#pragma unroll
                for (int j = 1; j < 16; ++j) mx = fmaxf(mx, s[hh][0][j]);
#pragma unroll
                for (int j = 0; j < 16; ++j) mx = fmaxf(mx, s[hh][1][j]);
                mx = fmaxf(mx, __shfl_xor(mx, 32));
                const float m_new = fmaxf(m_run[hh], mx);
                const float alpha = fast_exp2(m_run[hh] - m_new);
                m_run[hh] = m_new;
                float ls = 0.f;
#pragma unroll
                for (int kh = 0; kh < 2; ++kh)
#pragma unroll
                    for (int sp = 0; sp < 2; ++sp) {
                        float e[8];
#pragma unroll
                        for (int j = 0; j < 8; ++j) { e[j] = fast_exp2(s[hh][kh][sp * 8 + j] - m_new); ls += e[j]; }
                        u32x4 cv; cv.x = pk_bf16(e[0], e[1]); cv.y = pk_bf16(e[2], e[3]); cv.z = pk_bf16(e[4], e[5]); cv.w = pk_bf16(e[6], e[7]);
                        pf[hh][kh][sp] = __builtin_bit_cast(bf16x8, cv);
                    }
                l_run[hh] = l_run[hh] * alpha + ls;
                if (__builtin_amdgcn_ballot_w64(alpha != 1.f) != 0ull) {
#pragma unroll
                    for (int dh = 0; dh < 2; ++dh)
#pragma unroll
                        for (int j = 0; j < 16; ++j) o[hh][dh][j] *= alpha;
                }
            }
          }
#pragma unroll
            for (int dh = 0; dh < 2; ++dh)
#pragma unroll
                for (int kh = 0; kh < 2; ++kh)
#pragma unroll
                    for (int sp = 0; sp < 2; ++sp) {
                        const bf16x8 a = *(const bf16x8*)(sb + voff[kh * 2 + sp] + dh * 4096);
#pragma unroll
                        for (int hh = 0; hh < NH; ++hh) o[hh][dh] = __builtin_amdgcn_mfma_f32_32x32x16_bf16(a, pf[hh][kh][sp], o[hh][dh], 0, 0, 0);
                    }
        }
      }
        st = (st + NSUB) & RMASK;
    }
#undef ATT_ISSUE
  const int te = otid();
  const int wide = te >> 6, r31e = te & 31;
#pragma unroll
  for (int hh = 0; hh < NH; ++hh) {
    const float lt = l_run[hh] + __shfl_xor(l_run[hh], 32);
    const float inv = 1.f / lt;
    const bf16_t* zp = Z + (size_t)(wide * 32 + r31e) * ldz + hh * 64;
    bf16_t* op = O + (size_t)(wide * 32 + r31e) * ldo + hh * 64;
#pragma unroll
    for (int dh = 0; dh < 2; ++dh)
#pragma unroll
        for (int g = 0; g < 4; ++g) {
            const int d0 = dh * 32 + 8 * g + 4 * h;
            const uint2 zz = *(const uint2*)(zp + d0);
            const float z0 = __uint_as_float(zz.x << 16), z1 = __uint_as_float(zz.x & 0xffff0000u), z2 = __uint_as_float(zz.y << 16), z3 = __uint_as_float(zz.y & 0xffff0000u);
            uint2 w;
            w.x = pk_bf16(o[hh][dh][g * 4 + 0] * inv * z0, o[hh][dh][g * 4 + 1] * inv * z1);
            w.y = pk_bf16(o[hh][dh][g * 4 + 2] * inv * z2, o[hh][dh][g * 4 + 3] * inv * z3);
            *(uint2*)(op + d0) = w;
        }
  }
    __syncthreads();
}

__device__ void phase2(const Params& p, int c, unsigned char* smem) {
    const int G = gridDim.x;
    const int ntile = 256 + 512 + 256;
    const int nround = (ntile + G - 1) / G;
    const int S = c < 2 ? 16384 : 8192;
    const int sq0 = c < 2 ? c : 2 + 2 * (c - 2);
    bf16_t* H = WS_H(p);
    const float sbound = ((const float*)(p.ws + OFF_MISC))[0];
    float* sbias = (float*)(smem + 4 * 16384);
    for (int id = obid(); id < nround * G; id += G) {
        const int v = remap_id(id, G);
        if (v >= ntile) continue;
        NaInfo na; na.krow0 = 0; na.qrow = 0; na.q_wr = 0; na.bias = sbias;
        if (v < 256) {
            const int head = ((v >> 5) & 3) * 2, qb = (v >> 7) * 32 + (v & 31);
            const int t0 = qb * 256;
            const int ks = (t0 / S) * S;
            const int kvh = head >> 2;
            if (sbound <= 40.f) attn64<0, 2, true>(H + (size_t)t0 * LDH + C_QA + head * 64, LDH, WS_KA(p) + ((size_t)kvh * CH + ks) * 64, 64,
                              WS_VAT(p) + (size_t)(kvh * 64) * CH + ks, CH, S / 64,
                              H + (size_t)t0 * LDH + C_ZA + head * 64, LDH, H + (size_t)t0 * LDH + C_QA + head * 64, LDH, smem, na, sbound);
            else attn64<0, 2, false>(H + (size_t)t0 * LDH + C_QA + head * 64, LDH, WS_KA(p) + ((size_t)kvh * CH + ks) * 64, 64,
                              WS_VAT(p) + (size_t)(kvh * 64) * CH + ks, CH, S / 64,
                              H + (size_t)t0 * LDH + C_ZA + head * 64, LDH, H + (size_t)t0 * LDH + C_QA + head * 64, LDH, smem, na);
        } else if (v < 768) {
            const int v2 = v - 256;
            const int head = (v2 >> 5) & 7, qb = (v2 >> 8) * 32 + (v2 & 31);
            const int t0 = qb * 256;
            const int ss = (t0 / S) * S;
            const int rows = S / 64;
            const int r0 = (t0 - ss) / 64;
            const int rs = min(max(r0 - 4, 0), rows - 11);
            const int wid = otid() >> 6;
            na.krow0 = rs; na.qrow = r0 + (wid >> 1); na.q_wr = min(max(na.qrow - 4, 0), rows - 8);
            for (int i = otid(); i < 15 * 128; i += NTHREADS) {
                const int dr = i >> 7, x = (i & 127) - 48;
                sbias[i] = (x >= 0 && x < 31) ? p.rpb[(head * 15 + dr) * 31 + x] * LOG2E : 0.f;
            }
            __syncthreads();
            const int kt0 = ss + rs * 64;
            attn64<1, 1, false>(H + (size_t)t0 * LDH + C_QB + head * 64, LDH, H + (size_t)kt0 * LDH + C_KB + head * 64, LDH,
                              WS_VBT(p) + (size_t)(head * 64) * CH + kt0, CH, 11,
                              H + (size_t)t0 * LDH + C_ZB + head * 64, LDH, H + (size_t)t0 * LDH + C_QB + head * 64, LDH, smem, na);
        } else {
            const int v2 = v - 768;
            const int head = (v2 >> 5) & 3, qb = (v2 >> 7) * 32 + (v2 & 31);
            const int t0 = qb * 256;
            const int sq = sq0 + t0 / S;
            attn_block<128, 0>(H + (size_t)t0 * LDH + C_QM + head * 128, LDH, WS_KVM(p) + (size_t)sq * 256 * 512 + head * 128, 512,
                               WS_VMT(p) + ((size_t)sq * 512 + head * 128) * 256, 256, 4,
                               H + (size_t)t0 * LDH + C_ZM + head * 128, LDH, H + (size_t)t0 * LDH + C_QM + head * 128, LDH, smem, na);
        }
    }
}

__device__ void phase3(const Params& p, int c, unsigned char* smem) {
    const int G = gridDim.x;
    const int ntile = 64 * 4;
    const int nround = (ntile + G - 1) / G;
    for (int id = obid(); id < nround * G; id += G) {
        const int v = remap_id(id, G);
        if (v >= ntile) continue;
        const int tm = v >> 2, tn = v & 3;
        int rbase, cbase, ncol;
        wave_coords(tm * 256, tn * 256, rbase, cbase, ncol);
#pragma unroll 1
        for (int n = 0; n < 3; ++n) {
            const int seg = n == 0 ? C_QA : (n == 1 ? C_QB : C_QM);
            f32x4 acc[8][4];
            zero_acc(acc);
            gemm_mainloop(WS_H(p) + (size_t)tm * 256 * LDH + seg, LDH, WS_WBT(p) + (size_t)n * 1024 * 512 + (size_t)tn * 256 * 512, 512, 512, smem, acc);
            {
                const int tid = otid(), wid = tid >> 6, wr = wid >> 2, wc = wid & 3;
                const int rw = tm * 256 + wr * 128, cw = tn * 256 + wc * 64;
                const bf16_t* gp = WS_H(p) + (size_t)rw * LDH + C_G + n * 1024 + cw;
                bf16_t* mg = WS_MERGED(p) + (size_t)rw * DM + cw;
#pragma unroll
                for (int mp = 0; mp < 4; ++mp)
                    patch_pass(acc, mp, smem, [&](int row, int col, f32x4 v) {
                        const f32x4 gt = unpack4(*(const uint2*)(gp + (size_t)row * LDH + col));
                        uint2* mp2 = (uint2*)(mg + (size_t)row * DM + col);
                        v = v * gt;
                        if (n > 0) v = v + unpack4(*mp2);
                        *mp2 = pack4(v);
                    });
            }
        }
        asm volatile("s_waitcnt vmcnt(0)" ::: "memory");
        __syncthreads();
        if (otid() == 0) {
            __builtin_amdgcn_fence(__ATOMIC_RELEASE, "agent");
            asm volatile("s_waitcnt vmcnt(0)" ::: "memory");
            __hip_atomic_fetch_add((unsigned*)(p.ws + OFF_PANEL) + c * 64 + tm, 1u, __ATOMIC_RELAXED, __HIP_MEMORY_SCOPE_AGENT);
        }
    }
}

__device__ void phase4(const Params& p, int c, unsigned char* smem) {
    const int G = gridDim.x;
    const int ntile = 64 * 4;
    const int nround = (ntile + G - 1) / G;
    const float* x = c < 2 ? p.x_prompt + (size_t)c * CH * DM : p.x_sample + (size_t)(c - 2) * CH * DM;
    float* out = p.out + (size_t)c * CH * DM;
    for (int id = obid(); id < nround * G; id += G) {
        const int v = remap_id(id, G);
        if (v >= ntile) continue;
        const int tm = v >> 2, tn = v & 3;
        int rbase, cbase, ncol;
        wave_coords(tm * 256, tn * 256, rbase, cbase, ncol);
        if (otid() == 0) {
            const unsigned* pc = (const unsigned*)(p.ws + OFF_PANEL) + c * 64 + tm;
            for (unsigned spins = 0; spins < (1u << 22); ++spins) {
                if (__hip_atomic_load(pc, __ATOMIC_RELAXED, __HIP_MEMORY_SCOPE_AGENT) >= 4u) break;
                __builtin_amdgcn_s_sleep(0);
            }
            __builtin_amdgcn_fence(__ATOMIC_ACQUIRE, "agent");
            asm volatile("s_waitcnt vmcnt(0)" ::: "memory");
        }
        __syncthreads();
        f32x4 acc[8][4];
        zero_acc(acc);
        gemm_mainloop(WS_MERGED(p) + (size_t)tm * 256 * DM, DM, WS_WOT(p) + (size_t)tn * 256 * DM, DM, DM, smem, acc);
        {
            const int tid = otid(), wid = tid >> 6, wr = wid >> 2, wc = wid & 3;
            const size_t o0 = (size_t)(tm * 256 + wr * 128) * DM + tn * 256 + wc * 64;
#pragma unroll
            for (int mp = 0; mp < 4; ++mp)
                patch_pass(acc, mp, smem, [&](int row, int col, const f32x4 v) {
                    const size_t off = o0 + (size_t)row * DM + col;
                    const f32x4 xv = *(const f32x4*)(x + off);
                    *(f32x4*)(out + off) = xv * DN_ALPHA + v;
                });
        }
    }
}

__device__ void phase5(const Params& p, int c, int part, int nparts) {
    const int tid5 = otid(); const int lane = tid5 & 63, wid = tid5 >> 6;
    float* out = p.out + (size_t)c * CH * DM;
    f32x4 g[4], b[4];
#pragma unroll
    for (int i = 0; i < 4; ++i) { g[i] = *(const f32x4*)(p.ln_g + i * 256 + lane * 4); b[i] = *(const f32x4*)(p.ln_b + i * 256 + lane * 4); }
    for (int row = part * 8 + wid; row < CH; row += nparts * 8) {
        float* rp = out + (size_t)row * DM;
        f32x4 v[4];
#pragma unroll
        for (int i = 0; i < 4; ++i) v[i] = *(const f32x4*)(rp + i * 256 + lane * 4);
        float s = 0.f;
#pragma unroll
        for (int i = 0; i < 4; ++i) s += (v[i][0] + v[i][1]) + (v[i][2] + v[i][3]);
#pragma unroll
        for (int m = 1; m < 64; m <<= 1) s += __shfl_xor(s, m);
        const float mu = s * (1.f / 1024.f);
        float q = 0.f;
#pragma unroll
        for (int i = 0; i < 4; ++i) { const f32x4 d = v[i] - mu; q += (d[0] * d[0] + d[1] * d[1]) + (d[2] * d[2] + d[3] * d[3]); }
#pragma unroll
        for (int m = 1; m < 64; m <<= 1) q += __shfl_xor(q, m);
        const float rstd = rsqrtf(q * (1.f / 1024.f) + 1e-5f);
#pragma unroll
        for (int i = 0; i < 4; ++i) { const f32x4 y = (v[i] - mu) * rstd * g[i] + b[i]; *(f32x4*)(rp + i * 256 + lane * 4) = y; }
    }
}

DEVI void grid_barrier(unsigned* ctr, unsigned target) {
    asm volatile("s_waitcnt vmcnt(0) lgkmcnt(0)" ::: "memory");
    __syncthreads();
    if (threadIdx.x == 0) {
        __builtin_amdgcn_fence(__ATOMIC_RELEASE, "agent");
        asm volatile("s_waitcnt vmcnt(0)" ::: "memory");
        __hip_atomic_fetch_add(ctr, 1u, __ATOMIC_RELAXED, __HIP_MEMORY_SCOPE_AGENT);
        for (unsigned spins = 0; spins < (1u << 22); ++spins) {
            if (__hip_atomic_load(ctr, __ATOMIC_RELAXED, __HIP_MEMORY_SCOPE_AGENT) >= target) break;
            __builtin_amdgcn_s_sleep(0);
        }
        __builtin_amdgcn_fence(__ATOMIC_ACQUIRE, "agent");
        asm volatile("s_waitcnt vmcnt(0)" ::: "memory");
    }
    __syncthreads();
}

__global__ void __launch_bounds__(NTHREADS, 2) mega_fwd(Params p) {
    extern __shared__ __attribute__((aligned(16))) unsigned char smem[];
    cg::grid_group grid = cg::this_grid();
    phase0(p);
    grid.sync();
    unsigned* ctr = (unsigned*)(p.ws + OFF_BAR);
    unsigned target = 0;
    const unsigned nb = gridDim.x;
#pragma unroll 1
    for (int c = 0; c <= NCHUNK; ++c) {
        phase1(p, c, smem);
        if (c == NCHUNK) break;
        target += nb; grid_barrier(ctr, target);
        phase2(p, c, smem);
        target += nb; grid_barrier(ctr, target);
        phase3(p, c, smem);
        phase4(p, c, smem);
        target += nb; grid_barrier(ctr, target);
    }
}

extern "C" void kernel_launch(void* const* d_in, const int* in_sizes, int n_in, void* d_out, int out_size, void* d_ws, size_t ws_size, hipStream_t stream) {
    static int grid_blocks = 0;
    if (!grid_blocks) {
        int dev = 0, cus = 0, per_cu = 0;
        hipGetDevice(&dev);
        hipDeviceGetAttribute(&cus, hipDeviceAttributeMultiprocessorCount, dev);
        hipFuncSetAttribute((const void*)mega_fwd, hipFuncAttributeMaxDynamicSharedMemorySize, SMEM_BYTES);
        hipOccupancyMaxActiveBlocksPerMultiprocessor(&per_cu, (const void*)mega_fwd, NTHREADS, SMEM_BYTES);
        if (per_cu < 1) per_cu = 1;
        if (per_cu > 1) per_cu = 1;
        grid_blocks = cus * per_cu;
    }
    Params p{};
    p.x_prompt = (const float*)d_in[0]; p.x_sample = (const float*)d_in[1]; p.mem_prompt = (const float*)d_in[2]; p.mem_sample = (const float*)d_in[3];
    p.w_in = (const float*)d_in[4]; p.q_norm = (const float*)d_in[5]; p.k_norm = (const float*)d_in[6]; p.rpb = (const float*)d_in[7];
    p.w_mem_kv = (const float*)d_in[8]; p.w_branch = (const float*)d_in[9]; p.w_out = (const float*)d_in[10]; p.ln_g = (const float*)d_in[11]; p.ln_b = (const float*)d_in[12];
    p.out = (float*)d_out;
    p.ws = (unsigned char*)d_ws;
    if (ws_size < WS_END) { fprintf(stderr, "workspace too small\n"); return; }
    (void)hipMemsetAsync((unsigned char*)d_ws + OFF_BAR, 0, 256 + 256 + 2048, stream);
    void* args[] = {&p};
    hipError_t e = hipLaunchCooperativeKernel((void*)mega_fwd, dim3(grid_blocks), dim3(NTHREADS), args, SMEM_BYTES, stream);
    if (e != hipSuccess) fprintf(stderr, "cooperative launch failed: %s (grid %d)\n", hipGetErrorString(e), grid_blocks);
}
```
